# Optimizing an MI355X kernel written in HIP

```python
import jax, jax.numpy as jnp
from jax import lax
import numpy as np

D_MODEL = 1024
BATCH = 2
SEQ = 8192
DEPTH = 1

EPS = 1e-6
A_HEAD_DIM = 64
A_HEADS_PER_GROUP = 4
A_GROUPS = ((128, 1), (512, 4), (2048, 16))
A_HEADS = A_HEADS_PER_GROUP * len(A_GROUPS)
A_WIDTH = A_HEADS * A_HEAD_DIM
A_OUT = A_HEADS_PER_GROUP * A_HEAD_DIM
A_ROT_DIM = A_HEAD_DIM // 4
A_ROPE_THETA = 500000.0
B_HEADS = 8
B_NOPE = 64
B_ROPE = 32
B_QK = B_NOPE + B_ROPE
B_V = 64
B_Q_RANK = 512
B_KV_RANK = 256
B_ROPE_THETA = 10000.0
B_BLOCK = 128
B_OUT = B_HEADS * B_V
D_FF = 4 * D_MODEL
IN_A = 3 * A_WIDTH
IN_B = B_Q_RANK + B_KV_RANK + B_ROPE
IN_G = 2 * D_MODEL
IN_TOTAL = IN_A + IN_B + IN_G

kernel_name = "hybrid_dilated_swa_mla_block"


def rms_norm(x, g):
    xf = x.astype(jnp.float32)
    y = xf * lax.rsqrt(jnp.mean(xf * xf, axis=-1, keepdims=True) + EPS)
    return (y * g.astype(jnp.float32)).astype(x.dtype)


def rotary(x, pos, theta, rot_dim):
    half = rot_dim // 2
    inv = jnp.float32(theta) ** (-(jnp.arange(half, dtype=jnp.float32) * 2.0 / rot_dim))
    ang = pos.astype(jnp.float32)[:, None] * inv[None, :]
    cos = jnp.cos(ang)[:, None, :]
    sin = jnp.sin(ang)[:, None, :]
    xr = x[..., :rot_dim].astype(jnp.float32)
    x1, x2 = xr[..., :half], xr[..., half:]
    rot = jnp.concatenate([x1 * cos - x2 * sin, x2 * cos + x1 * sin], axis=-1).astype(x.dtype)
    return jnp.concatenate([rot, x[..., rot_dim:]], axis=-1)


def banded_attention(q, k, v, radius):
    N, L, H, D = q.shape
    C = radius
    nb = -(-L // C)
    Lp = nb * C
    qb = jnp.pad(q, ((0, 0), (0, Lp - L), (0, 0), (0, 0))).reshape(N, nb, C, H, D)
    pad_kv = ((0, 0), (C, Lp - L + C), (0, 0), (0, 0))
    kp = jnp.pad(k, pad_kv).reshape(N, nb + 2, C, H, D)
    vp = jnp.pad(v, pad_kv).reshape(N, nb + 2, C, H, D)
    kb = jnp.concatenate([kp[:, :-2], kp[:, 1:-1], kp[:, 2:]], axis=2)
    vb = jnp.concatenate([vp[:, :-2], vp[:, 1:-1], vp[:, 2:]], axis=2)
    q_idx = jnp.arange(nb)[:, None] * C + jnp.arange(C)[None, :]
    k_idx = jnp.arange(nb)[:, None] * C - C + jnp.arange(3 * C)[None, :]
    dist = q_idx[:, :, None] - k_idx[:, None, :]
    valid = (jnp.abs(dist) <= radius) & (k_idx[:, None, :] >= 0) & (k_idx[:, None, :] < L)
    s = jnp.einsum('nbqhd,nbkhd->nbhqk', qb, kb).astype(jnp.float32) * (D ** -0.5)
    s = jnp.where(valid[None, :, None], s, -jnp.inf)
    m = jnp.max(s, axis=-1, keepdims=True)
    p = jnp.exp(s - m)
    l = jnp.sum(p, axis=-1, keepdims=True)
    o = jnp.einsum('nbhqk,nbkhd->nbqhd', (p / l).astype(v.dtype), vb)
    lse = (m + jnp.log(l))[..., 0]
    o = o.reshape(N, Lp, H, D)[:, :L]
    lse = lse.transpose(0, 1, 3, 2).reshape(N, Lp, H)[:, :L]
    return o, lse


def dilated_group(q, k, v, window, dilation):
    B, S, H, D = q.shape
    L = S // dilation
    radius = window // (2 * dilation)

    def to_sub(t):
        return t.reshape(B, L, dilation, H, D).transpose(0, 2, 1, 3, 4).reshape(B * dilation, L, H, D)

    o, lse = banded_attention(to_sub(q), to_sub(k), to_sub(v), radius)
    o = o.reshape(B, dilation, L, H, D).transpose(0, 2, 1, 3, 4).reshape(B, S, H, D)
    lse = lse.reshape(B, dilation, L, H).transpose(0, 2, 1, 3).reshape(B, S, H)
    return o, lse


def mixer_dilated(qkv, pos):
    B, S, _ = qkv.shape
    q, k, v = jnp.split(qkv, 3, axis=-1)
    q = rotary(q.reshape(B, S, A_HEADS, A_HEAD_DIM), pos, A_ROPE_THETA, A_ROT_DIM)
    k = rotary(k.reshape(B, S, A_HEADS, A_HEAD_DIM), pos, A_ROPE_THETA, A_ROT_DIM)
    v = v.reshape(B, S, A_HEADS, A_HEAD_DIM)
    outs, lses = [], []
    for g, (window, dilation) in enumerate(A_GROUPS):
        hs = slice(g * A_HEADS_PER_GROUP, (g + 1) * A_HEADS_PER_GROUP)
        o, lse = dilated_group(q[:, :, hs], k[:, :, hs], v[:, :, hs], window, dilation)
        outs.append(o)
        lses.append(lse)
    o = jnp.stack(outs, axis=0)
    w = jax.nn.softmax(jnp.stack(lses, axis=0), axis=0)
    o = jnp.sum(w[..., None].astype(o.dtype) * o, axis=0)
    return o.reshape(B, S, A_OUT)


def mixer_mla(q_c, kv_c, k_pe, pos, q_norm, w_uq, kv_norm, w_ukv):
    B, S, _ = q_c.shape
    q = (rms_norm(q_c, q_norm) @ w_uq).reshape(B, S, B_HEADS, B_QK)
    q = jnp.concatenate([q[..., :B_NOPE], rotary(q[..., B_NOPE:], pos, B_ROPE_THETA, B_ROPE)], axis=-1)
    kv = (rms_norm(kv_c, kv_norm) @ w_ukv).reshape(B, S, B_HEADS, B_NOPE + B_V)
    k_nope, v = kv[..., :B_NOPE], kv[..., B_NOPE:]
    k_pe = rotary(k_pe[:, :, None, :], pos, B_ROPE_THETA, B_ROPE)
    k = jnp.concatenate([k_nope, jnp.broadcast_to(k_pe, (B, S, B_HEADS, B_ROPE))], axis=-1)
    k = k.transpose(0, 2, 1, 3)
    v = v.transpose(0, 2, 1, 3)
    nb = S // B_BLOCK
    q_blocks = q.transpose(0, 2, 1, 3).reshape(B, B_HEADS, nb, B_BLOCK, B_QK).transpose(2, 0, 1, 3, 4)
    scale = B_QK ** -0.5

    def block(qb):
        s = jnp.einsum('bhqd,bhkd->bhqk', qb, k).astype(jnp.float32) * scale
        p = jax.nn.softmax(s, axis=-1)
        return jnp.einsum('bhqk,bhkd->bhqd', p.astype(v.dtype), v)

    o = lax.map(block, q_blocks)
    return o.transpose(1, 0, 3, 2, 4).reshape(B, S, B_OUT)


def setup_inputs(seed: int = 0) -> dict:
    key = jax.random.key(seed)
    ks = jax.random.split(key, 18)
    f = jnp.float32

    def w(k, shape):
        return jax.random.normal(k, shape, f) * (shape[0] ** -0.5)

    def gain(k, n):
        return 1.0 + 0.05 * jax.random.normal(k, (n,), f)

    return {
        "x": jax.random.normal(ks[0], (BATCH, SEQ, D_MODEL), f),
        "norm_mix_pre": gain(ks[1], D_MODEL),
        "w_in": w(ks[2], (D_MODEL, IN_TOTAL)),
        "b_gate": 0.02 * jax.random.normal(ks[3], (IN_G,), f),
        "mla_q_norm": gain(ks[4], B_Q_RANK),
        "mla_w_uq": w(ks[5], (B_Q_RANK, B_HEADS * B_QK)),
        "mla_kv_norm": gain(ks[6], B_KV_RANK),
        "mla_w_ukv": w(ks[7], (B_KV_RANK, B_HEADS * (B_NOPE + B_V))),
        "w_o_a": w(ks[8], (A_OUT, D_MODEL)),
        "w_o_b": w(ks[9], (B_OUT, D_MODEL)),
        "w_out": w(ks[10], (D_MODEL, D_MODEL)),
        "norm_mix_post": gain(ks[11], D_MODEL),
        "norm_mlp_pre": gain(ks[12], D_MODEL),
        "w_ff1": w(ks[13], (D_MODEL, D_FF)),
        "w_ff2": w(ks[14], (D_FF, D_MODEL)),
        "norm_mlp_post": gain(ks[15], D_MODEL),
    }


def reference(x, norm_mix_pre, w_in, b_gate, mla_q_norm, mla_w_uq, mla_kv_norm, mla_w_ukv,
              w_o_a, w_o_b, w_out, norm_mix_post, norm_mlp_pre, w_ff1, w_ff2, norm_mlp_post):
    B, S, D = x.shape
    pos = jnp.arange(S, dtype=jnp.int32)
    h = x
    for _ in range(DEPTH):
        xn = rms_norm(h, norm_mix_pre)
        proj = xn @ w_in
        qkv_a = proj[..., :IN_A]
        q_c = proj[..., IN_A:IN_A + B_Q_RANK]
        kv_c = proj[..., IN_A + B_Q_RANK:IN_A + B_Q_RANK + B_KV_RANK]
        k_pe = proj[..., IN_A + B_Q_RANK + B_KV_RANK:IN_A + IN_B]
        gates = jax.nn.sigmoid(proj[..., IN_A + IN_B:] + b_gate)
        g_a, g_b = gates[..., :D_MODEL], gates[..., D_MODEL:]
        o_a = mixer_dilated(qkv_a, pos) @ w_o_a
        o_b = mixer_mla(q_c, kv_c, k_pe, pos, mla_q_norm, mla_w_uq, mla_kv_norm, mla_w_ukv) @ w_o_b
        mix = (g_a * o_a + g_b * o_b) @ w_out
        h = h + rms_norm(mix, norm_mix_post)
        hn = rms_norm(h, norm_mlp_pre)
        ff = jnp.square(jax.nn.relu(hn @ w_ff1)) @ w_ff2
        h = h + rms_norm(ff, norm_mlp_post)
    return h
```

```cpp
#include <hip/hip_runtime.h>
#include <hip/hip_bf16.h>
#include <cstdio>
#include <cstdint>
#include <cmath>

#ifndef MK_N_LAUNCHES
#define MK_N_LAUNCHES 10
#endif

#define LAS __attribute__((address_space(3)))
#define GAS __attribute__((address_space(1)))
typedef unsigned short bf16_t;
typedef short bf16x8 __attribute__((ext_vector_type(8)));
typedef short s16x4 __attribute__((ext_vector_type(4)));
typedef float f32x4 __attribute__((ext_vector_type(4)));
typedef float f32x16 __attribute__((ext_vector_type(16)));
typedef unsigned u32x4 __attribute__((ext_vector_type(4)));
typedef unsigned u32x2 __attribute__((ext_vector_type(2)));
typedef float f32x2_t __attribute__((ext_vector_type(2)));
typedef __bf16 bf16x2_t __attribute__((ext_vector_type(2)));

constexpr int SEQ = 8192, NB = 2, M = NB * SEQ, DM = 1024, FF = 4096;
constexpr int IN_TOTAL = 5152;
constexpr int NPROJ = 5376;
constexpr int LD_QKVA = 2304, LD_QC = 512, LD_KVC = 256, LD_G = 2048, LD_KPE = 32, LD_MQ = 768, LD_MKV = 1024, LD_MIX = 768;
constexpr float EPS = 1e-6f;
constexpr float LOG2E = 1.4426950408889634f;
constexpr float QSCALE_A = 0.125f * LOG2E;
constexpr float QSCALE_B = 0.10206207261596577f * LOG2E;

constexpr size_t MiB = 1u << 20;
constexpr size_t WS_CTL = 0, CTL_ZERO_BYTES = 64 * 1024;
constexpr size_t WS_WIN = 256 * 1024;
constexpr size_t WS_WUQ = WS_WIN + (size_t)NPROJ * 1024 * 2;
constexpr size_t WS_WUKV = WS_WUQ + (size_t)768 * 512 * 2;
constexpr size_t WS_WO = WS_WUKV + (size_t)1024 * 256 * 2;
constexpr size_t WS_WOUT = WS_WO + (size_t)1024 * 768 * 2;
constexpr size_t WS_WF1 = WS_WOUT + (size_t)1024 * 1024 * 2;
constexpr size_t WS_WF2 = WS_WF1 + (size_t)4096 * 1024 * 2;
constexpr size_t WS_CSA = WS_WF2 + (size_t)4096 * 1024 * 2;
constexpr size_t WS_CSB = WS_CSA + (size_t)8192 * 16 * 4;
constexpr size_t WS_SSQ = WS_CSB + (size_t)8192 * 32 * 4;
constexpr size_t WS_WEND = WS_SSQ + (size_t)M * 16 * 4;
static_assert(WS_WEND <= 34 * MiB, "weights region");
constexpr size_t WS_XN = 34 * MiB;
constexpr size_t WS_QKVA = 66 * MiB;
constexpr size_t WS_QC = 138 * MiB;
constexpr size_t WS_KVC = 154 * MiB;
constexpr size_t WS_KPE = 162 * MiB;
constexpr size_t WS_MQ = 163 * MiB;
constexpr size_t WS_MIX = 187 * MiB;
constexpr size_t WS_U = 211 * MiB;
constexpr size_t WS_F32 = 66 * MiB;
constexpr size_t WS_HN = 224 * MiB;
constexpr size_t WS_HID = 34 * MiB;
constexpr size_t WS_FFO = 162 * MiB;
static_assert(WS_U + (size_t)M * 1024 * 2 <= 256 * MiB && WS_HN + (size_t)M * 1024 * 2 <= 256 * MiB, "ws");

namespace pg8 {
constexpr int BM = 256, BK = 64, HALF = 128, HTB = HALF * BK * 2, STAGE_BYTES = 8 * HTB, NXCD = 8, WGM = 8;
__host__ __device__ __forceinline__ int lds_byte(int r, int c) { const int st = (r >> 4) * 2 + (c >> 5), rr = r & 15, cc = c & 31, ob = rr * 64 + cc * 2; return st * 1024 + (ob ^ (((ob >> 9) & 1) << 5)); }
__host__ __device__ __forceinline__ void stage_rc(int b, int& R, int& C) { const int st = b / 1024, sb = b % 1024, swz = sb ^ (((sb >> 9) & 1) << 5); R = (st >> 1) * 16 + swz / 64; C = (st & 1) * 32 + (swz % 64) / 2; }
__host__ __device__ __forceinline__ int perm32(int rho) { const int n = rho >> 4, i = rho & 15; return 8 * (i >> 2) + 4 * n + (i & 3); }
struct Unit { int pm, pn; };
struct Gemm { const bf16_t* A; const bf16_t* Bt; int lda, ldb, K; };
struct StaticOrder {
    int nM, nN, nwg, G, c;
    __device__ void init(int M_, int N_, int G_, int c_) { nM = M_ / BM; nN = N_ / BM; nwg = nM * nN; G = G_; c = c_; }
    __device__ bool next(int i, Unit& u) const {
        const long L = (long)i * G + c; if (L >= nwg) return false;
        int wgid = (int)L; { const int q = nwg / NXCD, r = nwg % NXCD, xcd = wgid % NXCD, off = wgid / NXCD; wgid = (xcd < r ? xcd * (q + 1) : r * (q + 1) + (xcd - r) * q) + off; }
        const int nig = WGM * nN, gid = wgid / nig, fm = gid * WGM, gsz = (nM - fm) < WGM ? (nM - fm) : WGM;
        u.pm = fm + ((wgid % nig) % gsz); u.pn = (wgid % nig) / gsz; return true;
    }
};
__device__ __forceinline__ unsigned cvt_pk_bf16(float lo, float hi) { f32x2_t v = {lo, hi}; bf16x2_t b = __builtin_convertvector(v, bf16x2_t); return __builtin_bit_cast(unsigned, b); }
__device__ __forceinline__ float bf_lo(unsigned w) { return __uint_as_float(w << 16); }
__device__ __forceinline__ float bf_hi(unsigned w) { return __uint_as_float(w & 0xffff0000u); }

struct EpiArgs {
    bf16_t *o0, *o1, *o2, *o3, *o4;
    float* f0; float* ssq; const float* bias; const float* csa; const float* csb; const bf16_t* gates;
};
template <int MODE> struct Epi {
    static constexpr bool PERM = true;
    EpiArgs a;
    __device__ __forceinline__ void store8(bf16_t* p, const float (&v)[8]) const {
        u32x4 w; w.x = cvt_pk_bf16(v[0], v[1]); w.y = cvt_pk_bf16(v[2], v[3]); w.z = cvt_pk_bf16(v[4], v[5]); w.w = cvt_pk_bf16(v[6], v[7]); *(u32x4*)p = w;
    }
    __device__ __forceinline__ void operator()(const f32x4 (&acc)[2][2][4][2], const Unit& u, int wr, int wc, int fr, int fq) const {
        const int pn = u.pn;
#pragma unroll
        for (int ai = 0; ai < 2; ++ai)
#pragma unroll
            for (int m = 0; m < 4; ++m) {
                const int row = u.pm * BM + ai * HALF + wr * 64 + m * 16 + fr;
                const int pos = row & (SEQ - 1);
                float rs = 1.f;
                if (MODE == 1) { const f32x4 s0 = *(const f32x4*)(a.ssq + (size_t)row * 16), s1 = *(const f32x4*)(a.ssq + (size_t)row * 16 + 4);
                    const float s = ((s0[0] + s0[1]) + (s0[2] + s0[3])) + ((s1[0] + s1[1]) + (s1[2] + s1[3])); rs = __builtin_amdgcn_rsqf(s * (1.f / 512.f) + EPS) * QSCALE_B; }
                if (MODE == 2) { const f32x4 s0 = *(const f32x4*)(a.ssq + (size_t)row * 16 + 8); const float s = (s0[0] + s0[1]) + (s0[2] + s0[3]); rs = __builtin_amdgcn_rsqf(s * (1.f / 256.f) + EPS); }
                float sq = 0.f;
#pragma unroll
                for (int bj = 0; bj < 2; ++bj) {
                    const int ct = bj * HALF + wc * 32 + 8 * fq;
                    float v[8];
#pragma unroll
                    for (int j = 0; j < 4; ++j) { v[j] = acc[ai][bj][m][0][j]; v[4 + j] = acc[ai][bj][m][1][j]; }
                    if (MODE == 0) {
                        if (pn < 6) {
                            if ((wc & 1) == 0) {
                                float c[8], s[8];
                                if (fq < 2) {
#pragma unroll
                                    for (int j = 0; j < 8; j += 4) { const f32x4 cc = *(const f32x4*)(a.csa + pos * 16 + j), ss = *(const f32x4*)(a.csa + pos * 16 + 8 + j);
#pragma unroll
                                        for (int e = 0; e < 4; ++e) { c[j + e] = cc[e]; s[j + e] = ss[e]; } }
                                } else {
#pragma unroll
                                    for (int j = 0; j < 8; ++j) { c[j] = 1.f; s[j] = 0.f; }
                                }
                                const float sg = (fq == 0) ? -1.f : 1.f;
#pragma unroll
                                for (int j = 0; j < 8; ++j) { const float p = __shfl_xor(v[j], 16); v[j] = v[j] * c[j] + sg * p * s[j]; }
                            }
                            if (pn < 3) {
#pragma unroll
                                for (int j = 0; j < 8; ++j) v[j] *= QSCALE_A;
                            }
                            store8(a.o0 + (size_t)row * LD_QKVA + pn * BM + ct, v);
                        } else if (pn < 9) {
                            store8(a.o0 + (size_t)row * LD_QKVA + pn * BM + ct, v);
                        } else if (pn < 12) {
#pragma unroll
                            for (int j = 0; j < 8; ++j) sq += v[j] * v[j];
                            if (pn < 11) store8(a.o1 + (size_t)row * LD_QC + (pn - 9) * BM + ct, v);
                            else store8(a.o2 + (size_t)row * LD_KVC + ct, v);
                        } else if (pn < 20) {
                            const int gc = (pn - 12) * BM + ct;
                            const f32x4 b0 = *(const f32x4*)(a.bias + gc), b1 = *(const f32x4*)(a.bias + gc + 4);
#pragma unroll
                            for (int j = 0; j < 4; ++j) { v[j] = __builtin_amdgcn_rcpf(1.f + __builtin_amdgcn_exp2f(-(v[j] + b0[j]) * LOG2E)); v[4 + j] = __builtin_amdgcn_rcpf(1.f + __builtin_amdgcn_exp2f(-(v[4 + j] + b1[j]) * LOG2E)); }
                            store8(a.o3 + (size_t)row * LD_G + gc, v);
                        } else {
                            if (wc == 0 && bj == 0) {
                                const int fi = 8 * (fq & 1);
                                const float sg = (fq < 2) ? -1.f : 1.f;
#pragma unroll
                                for (int j = 0; j < 8; ++j) { const float p = __shfl_xor(v[j], 32); const float c = a.csb[pos * 32 + fi + j], s = a.csb[pos * 32 + 16 + fi + j]; v[j] = v[j] * c + sg * p * s; }
                                store8(a.o4 + (size_t)row * LD_KPE + 8 * fq, v);
                            }
                        }
                    } else if (MODE == 1) {
#pragma unroll
                        for (int j = 0; j < 8; ++j) v[j] *= rs;
                        const int g32 = 8 * pn + 4 * bj + wc;
                        if ((g32 % 3) == 2) {
                            const int fi = 8 * (fq & 1);
                            const float sg = (fq < 2) ? -1.f : 1.f;
#pragma unroll
                            for (int j = 0; j < 8; ++j) { const float p = __shfl_xor(v[j], 32); const float c = a.csb[pos * 32 + fi + j], s = a.csb[pos * 32 + 16 + fi + j]; v[j] = v[j] * c + sg * p * s; }
                        }
                        store8(a.o0 + (size_t)row * LD_MQ + pn * BM + ct, v);
                    } else if (MODE == 2) {
#pragma unroll
                        for (int j = 0; j < 8; ++j) v[j] *= rs;
                        store8(a.o0 + (size_t)row * LD_MKV + pn * BM + ct, v);
                    } else if (MODE == 3 || MODE == 4) {
                        const int col = pn * BM + ct;
                        const u32x4 g = *(const u32x4*)(a.gates + (size_t)row * LD_G + (MODE == 4 ? 1024 : 0) + col);
                        float gg[8] = {bf_lo(g.x), bf_hi(g.x), bf_lo(g.y), bf_hi(g.y), bf_lo(g.z), bf_hi(g.z), bf_lo(g.w), bf_hi(g.w)};
                        bf16_t* up = a.o0 + (size_t)row * 1024 + col;
                        if (MODE == 4) { const u32x4 o = *(const u32x4*)up; const float oo[8] = {bf_lo(o.x), bf_hi(o.x), bf_lo(o.y), bf_hi(o.y), bf_lo(o.z), bf_hi(o.z), bf_lo(o.w), bf_hi(o.w)};
#pragma unroll
                            for (int j = 0; j < 8; ++j) v[j] = oo[j] + gg[j] * v[j];
                        } else {
#pragma unroll
                            for (int j = 0; j < 8; ++j) v[j] = gg[j] * v[j];
                        }
                        store8(up, v);
                    } else if (MODE == 5) {
#pragma unroll
                        for (int j = 0; j < 8; ++j) sq += v[j] * v[j];
                        float* op = a.f0 + (size_t)row * 1024 + pn * BM + ct;
                        *(f32x4*)op = (f32x4){v[0], v[1], v[2], v[3]}; *(f32x4*)(op + 4) = (f32x4){v[4], v[5], v[6], v[7]};
                    } else if (MODE == 6) {
#pragma unroll
                        for (int j = 0; j < 8; ++j) { const float r = fmaxf(v[j], 0.f); v[j] = r * r; }
                        store8(a.o0 + (size_t)row * FF + pn * BM + ct, v);
                    }
                }
                if (MODE == 3 || MODE == 4) asm volatile("" ::: "memory");
                if (MODE == 5 || (MODE == 0 && pn >= 9 && pn < 12)) {
                    sq += __shfl_xor(sq, 16); sq += __shfl_xor(sq, 32);
                    const int slot = (MODE == 5) ? (pn * 4 + wc) : ((pn - 9) * 4 + wc);
                    if (fq == 0) a.ssq[(size_t)row * 16 + slot] = sq;
                }
            }
    }
};

template <class EpiT>
__device__ __forceinline__ void gemm_phase(LAS unsigned char* lds, const Gemm g, const StaticOrder& S, const EpiT& E) {
    const int tid = threadIdx.x, wid = __builtin_amdgcn_readfirstlane(tid >> 6), lane = tid & 63, wr = wid >> 2, wc = wid & 3, fr = lane & 15, fq = lane >> 4;
    int nt = g.K / BK; asm volatile("" : "+s"(nt));
    unsigned voffA[2], voffB[2];
#pragma unroll
    for (int i = 0; i < 2; ++i) { int R, C; stage_rc(tid * 16 + i * 8192, R, C); const int Rb = EpiT::PERM ? ((R & ~31) + perm32(R & 31)) : R;
        voffA[i] = (unsigned)(R * g.lda + C) * 2u; voffB[i] = (unsigned)(Rb * g.ldb + C) * 2u; }
    const size_t kstep = (size_t)(BK * 2);
    const size_t hstepA = (size_t)HALF * g.lda * 2, hstepB = (size_t)HALF * g.ldb * 2;
    const size_t tstepA = 2 * hstepA, tstepB = 2 * hstepB;
    const unsigned ldsw = (unsigned)wid * 1024u;
    const int aoff = lds_byte(wr * 64 + fr, fq * 8), boff = lds_byte(wc * 32 + fr, fq * 8);
#define PG8_SA(b, h) (((b) * 2 + (h)) * HTB)
#define PG8_SB(b, h) ((4 + (b) * 2 + (h)) * HTB)
#define PG8_STAGE(bufoff, gbase, voff) do { _Pragma("unroll") for (int _i = 0; _i < 2; ++_i) \
        __builtin_amdgcn_global_load_lds((const unsigned*)((const char*)(gbase) + (voff)[_i]), (LAS unsigned*)(lds + (bufoff) + ldsw + _i * 8192), 16, 0, 0); } while (0)
#define PG8_LDA(dst, b, h) do { _Pragma("unroll") for (int m = 0; m < 4; ++m) _Pragma("unroll") for (int k = 0; k < 2; ++k) dst[m][k] = *(const LAS bf16x8*)(lds + PG8_SA(b, h) + aoff + m * 2048 + k * 1024); } while (0)
#define PG8_LDB(dst, b, h) do { _Pragma("unroll") for (int n = 0; n < 2; ++n) _Pragma("unroll") for (int k = 0; k < 2; ++k) dst[n][k] = *(const LAS bf16x8*)(lds + PG8_SB(b, h) + boff + n * 2048 + k * 1024); } while (0)
#define PG8_MMA(ai, bj, At, Bt) do { __builtin_amdgcn_s_setprio(1); _Pragma("unroll") for (int m = 0; m < 4; ++m) _Pragma("unroll") for (int n = 0; n < 2; ++n) _Pragma("unroll") for (int k = 0; k < 2; ++k) \
        acc[ai][bj][m][n] = __builtin_amdgcn_mfma_f32_16x16x32_bf16(Bt[n][k], At[m][k], acc[ai][bj][m][n], 0, 0, 0); __builtin_amdgcn_s_setprio(0); } while (0)
#define PG8_WAIT_V(n) asm volatile("s_waitcnt vmcnt(" #n ")" ::: "memory")
#define PG8_WAIT_L(n) asm volatile("s_waitcnt lgkmcnt(" #n ")" ::: "memory")
#define PG8_BAR __builtin_amdgcn_s_barrier()
#define PG8_SCHED __builtin_amdgcn_sched_barrier(0)
    Unit cur, nxt; int ui = 0;
    if (!S.next(0, cur)) return;
    f32x4 acc[2][2][4][2];
#pragma unroll
    for (int a = 0; a < 2; ++a)
#pragma unroll
        for (int b = 0; b < 2; ++b)
#pragma unroll
            for (int m = 0; m < 4; ++m)
#pragma unroll
                for (int n = 0; n < 2; ++n) acc[a][b][m][n] = (f32x4){0.f, 0.f, 0.f, 0.f};
    bf16x8 At[4][2], B0[2][2], B1[2][2];
    const char* cA = (const char*)g.A + (size_t)cur.pm * tstepA; const char* cB = (const char*)g.Bt + (size_t)cur.pn * tstepB;
    PG8_STAGE(PG8_SB(0, 0), cB, voffB); PG8_STAGE(PG8_SB(0, 1), cB + hstepB, voffB); PG8_STAGE(PG8_SA(0, 0), cA, voffA); PG8_STAGE(PG8_SA(0, 1), cA + hstepA, voffA);
    if (wr == 1) PG8_BAR;
    PG8_WAIT_V(2); PG8_BAR;
    PG8_STAGE(PG8_SB(1, 0), cB + kstep, voffB); PG8_STAGE(PG8_SA(1, 0), cA + kstep, voffA); PG8_STAGE(PG8_SB(1, 1), cB + hstepB + kstep, voffB);
    PG8_WAIT_V(6); PG8_BAR;
    for (;;) {
        const bool has_next = S.next(ui + 1, nxt);
        const char* nA = has_next ? (const char*)g.A + (size_t)nxt.pm * tstepA : cA; const char* nB = has_next ? (const char*)g.Bt + (size_t)nxt.pn * tstepB : cB;
        for (int t = 0; t < nt; t += 2) {
            const bool last = (t == nt - 2);
            const char* a1 = cA + (size_t)(t + 1) * kstep;
            const char* a2 = last ? nA : cA + (size_t)(t + 2) * kstep; const char* b2 = last ? nB : cB + (size_t)(t + 2) * kstep;
            const char* a3 = a2 + kstep; const char* b3 = b2 + kstep;
            PG8_LDB(B0, 0, 0); PG8_LDB(B1, 0, 1); PG8_SCHED; PG8_LDA(At, 0, 0); PG8_STAGE(PG8_SA(1, 1), a1 + hstepA, voffA);
            PG8_WAIT_V(8); PG8_WAIT_L(0); PG8_BAR; PG8_MMA(0, 0, At, B0); PG8_MMA(0, 1, At, B1); PG8_BAR; PG8_SCHED;
            PG8_LDA(At, 0, 1); PG8_STAGE(PG8_SB(0, 0), b2, voffB); PG8_STAGE(PG8_SB(0, 1), b2 + hstepB, voffB); PG8_STAGE(PG8_SA(0, 0), a2, voffA);
            PG8_WAIT_V(8); PG8_WAIT_L(0); PG8_BAR; PG8_MMA(1, 0, At, B0); PG8_MMA(1, 1, At, B1); PG8_BAR; PG8_SCHED;
            PG8_LDB(B0, 1, 0); PG8_LDB(B1, 1, 1); PG8_SCHED; PG8_LDA(At, 1, 0); PG8_STAGE(PG8_SA(0, 1), a2 + hstepA, voffA);
            PG8_WAIT_V(8); PG8_WAIT_L(0); PG8_BAR; PG8_MMA(0, 0, At, B0); PG8_MMA(0, 1, At, B1); PG8_BAR; PG8_SCHED;
            PG8_LDA(At, 1, 1); PG8_STAGE(PG8_SB(1, 0), b3, voffB); PG8_STAGE(PG8_SB(1, 1), b3 + hstepB, voffB); PG8_STAGE(PG8_SA(1, 0), a3, voffA);
            PG8_WAIT_V(8); PG8_WAIT_L(0); PG8_BAR; PG8_MMA(1, 0, At, B0); PG8_MMA(1, 1, At, B1); PG8_BAR; PG8_SCHED;
        }
        if (wr == 0) PG8_BAR;
        E(acc, cur, wr, wc, fr, fq);
        if (!has_next) break;
#pragma unroll
        for (int a = 0; a < 2; ++a)
#pragma unroll
            for (int b = 0; b < 2; ++b)
#pragma unroll
                for (int m = 0; m < 4; ++m)
#pragma unroll
                    for (int n = 0; n < 2; ++n) acc[a][b][m][n] = (f32x4){0.f, 0.f, 0.f, 0.f};
        cur = nxt; cA = nA; cB = nB; ++ui;
        if (wr == 1) PG8_BAR;
    }
    PG8_WAIT_V(0);
    PG8_BAR;
#undef PG8_SA
#undef PG8_SB
#undef PG8_STAGE
#undef PG8_LDA
#undef PG8_LDB
#undef PG8_MMA
#undef PG8_WAIT_V
#undef PG8_WAIT_L
#undef PG8_BAR
#undef PG8_SCHED
}
}

namespace att {
typedef LAS const char* lds_cptr;
typedef short v4i16_t __attribute__((ext_vector_type(4)));
__device__ __forceinline__ int crow(int r, int hi) { return (r & 3) + 8 * (r >> 2) + 4 * hi; }
__device__ __forceinline__ void glds16(const void* gsrc, unsigned lds_dst) { unsigned keep;
    asm volatile("s_mov_b32 %0, m0\n\ts_mov_b32 m0, %2\n\ts_nop 0\n\tglobal_load_lds_dwordx4 %1, off\n\ts_mov_b32 m0, %0" : "=&s"(keep) : "v"(gsrc), "s"(lds_dst) : "memory"); }
__device__ __forceinline__ unsigned cvtpk(float lo, float hi) { return pg8::cvt_pk_bf16(lo, hi); }
__device__ __forceinline__ s16x4 vtr(lds_cptr p) { return __builtin_bit_cast(s16x4, __builtin_amdgcn_ds_read_tr16_b64_v4i16((LAS v4i16_t*)p)); }
__device__ __forceinline__ float halfmax(float m) { auto rr = __builtin_amdgcn_permlane32_swap(__float_as_uint(m), __float_as_uint(m), false, false); return fmaxf(__uint_as_float(rr[0]), __uint_as_float(rr[1])); }
__device__ __forceinline__ float halfsum(float m) { auto rr = __builtin_amdgcn_permlane32_swap(__float_as_uint(m), __float_as_uint(m), false, false); return __uint_as_float(rr[0]) + __uint_as_float(rr[1]); }
#define WAIT_BAR(N) asm volatile("s_waitcnt vmcnt(" #N ") lgkmcnt(0)\n\ts_barrier" ::: "memory")
#define VFRAG(lo, hi) (bf16x8){lo[0], lo[1], lo[2], lo[3], hi[0], hi[1], hi[2], hi[3]}

constexpr int NSLOT = 3, KSLOT = 12288, VSLOT = 8192;
constexpr int LDS_K = 0, LDS_V = NSLOT * KSLOT, LDS_OST = LDS_V + NSLOT * VSLOT, OST_W = 32 * 144, LDS_END = LDS_OST + 8 * OST_W;
static_assert(LDS_END <= 131072, "attention LDS");
constexpr float THRL = 8.f;

__device__ __forceinline__ void mla_unit(int b, int h, int qb, const bf16_t* MQ, const bf16_t* MKV, const bf16_t* KPE, bf16_t* MIX, LAS unsigned char* shm) {
    const int tid = threadIdx.x, lane = tid & 63, r32 = lane & 31, hi = lane >> 5; const int wid = __builtin_amdgcn_readfirstlane(tid >> 6);
    const long rowbase = (long)b * SEQ; const int q0 = qb * 256;
    const bf16_t* Qw = MQ + (rowbase + q0 + wid * 32) * LD_MQ + h * 96;
    const unsigned lds0 = (unsigned)(uintptr_t)shm;
    const bf16_t* ksrc0 = MKV + (rowbase + lane) * LD_MKV + h * 128 + wid * 8;
    const bf16_t* ksrc1 = KPE + (rowbase + lane) * LD_KPE + (wid & 3) * 8;
    const bf16_t* vsrc = MKV + (rowbase + 16 * (wid & 3) + (lane >> 2)) * LD_MKV + h * 128 + 64 + (wid >> 2) * 32 + (lane & 3) * 8;
    const unsigned kdst0 = lds0 + LDS_K + wid * 1024, kdst1 = lds0 + LDS_K + (8 + (wid & 3)) * 1024, vdst = lds0 + LDS_V + wid * 1024;
#define DMA_T(t, s) do { glds16(ksrc0 + (long)(t) * 64 * LD_MKV, (unsigned)__builtin_amdgcn_readfirstlane(kdst0 + (s) * KSLOT)); \
                         glds16(ksrc1 + (long)(t) * 64 * LD_KPE, (unsigned)__builtin_amdgcn_readfirstlane(kdst1 + (s) * KSLOT)); \
                         glds16(vsrc + (long)(t) * 64 * LD_MKV, (unsigned)__builtin_amdgcn_readfirstlane(vdst + (s) * VSLOT)); } while (0)
    const lds_cptr shm3 = (lds_cptr)shm;
    const lds_cptr kp0 = shm3 + LDS_K + hi * 1024 + r32 * 16;
    const lds_cptr vp0 = shm3 + LDS_V + ((lane >> 4) & 1) * 32 + (lane & 3) * 8 + (4 * hi + ((lane & 15) >> 2)) * 64;
    constexpr int NT = SEQ / 64;
    DMA_T(0, 0); DMA_T(1, 1);
    bf16x8 qr[6];
#pragma unroll
    for (int d0 = 0; d0 < 6; ++d0) qr[d0] = *(const bf16x8*)(Qw + (long)r32 * LD_MQ + d0 * 16 + hi * 8);
    float mhat = 0.f, l_reg = 0.f; f32x16 o[2]; o[0] = f32x16{}; o[1] = f32x16{}; f32x16 negm = f32x16{};
    int sl = 0;
#pragma unroll 1
    for (int t = 0; t < NT; ++t) {
        if (t + 1 < NT) WAIT_BAR(3); else WAIT_BAR(0);
        { int s2 = sl + 2; if (s2 >= 3) s2 -= 3; if (t + 2 < NT) DMA_T(t + 2, s2); }
        f32x16 C0 = negm, C1 = negm;
        const lds_cptr kp = kp0 + sl * KSLOT;
#pragma unroll
        for (int d0 = 0; d0 < 6; ++d0) {
            const bf16x8 k0 = *(const LAS bf16x8*)(kp + d0 * 2048), k1 = *(const LAS bf16x8*)(kp + d0 * 2048 + 512);
            C0 = __builtin_amdgcn_mfma_f32_32x32x16_bf16(k0, qr[d0], C0, 0, 0, 0);
            C1 = __builtin_amdgcn_mfma_f32_32x32x16_bf16(k1, qr[d0], C1, 0, 0, 0);
        }
        float rm = fmaxf(C0[0], C1[0]);
#pragma unroll
        for (int r = 1; r < 16; ++r) rm = fmaxf(rm, fmaxf(C0[r], C1[r]));
        rm = halfmax(rm);
        if (t == 0 || __any(rm > THRL)) {
            const float dl = (t == 0) ? rm : fmaxf(rm, 0.f);
            mhat += dl;
#pragma unroll
            for (int r = 0; r < 16; ++r) { C0[r] -= dl; C1[r] -= dl; negm[r] = -mhat; }
            if (t > 0) { const float f = __builtin_amdgcn_exp2f(-dl); l_reg *= f;
#pragma unroll
                for (int r = 0; r < 16; ++r) { o[0][r] *= f; o[1][r] *= f; } }
        }
        float sacc = 0.f;
#pragma unroll
        for (int r = 0; r < 16; ++r) { C0[r] = __builtin_amdgcn_exp2f(C0[r]); C1[r] = __builtin_amdgcn_exp2f(C1[r]); sacc += C0[r] + C1[r]; }
        l_reg += sacc;
        u32x4 pw[4];
#pragma unroll
        for (int k = 0; k < 4; ++k) { pw[0][k] = cvtpk(C0[2 * k], C0[2 * k + 1]); pw[1][k] = cvtpk(C0[8 + 2 * k], C0[9 + 2 * k]); pw[2][k] = cvtpk(C1[2 * k], C1[2 * k + 1]); pw[3][k] = cvtpk(C1[8 + 2 * k], C1[9 + 2 * k]); }
        const lds_cptr vp = vp0 + sl * VSLOT;
#pragma unroll
        for (int d0 = 0; d0 < 2; ++d0)
#pragma unroll
            for (int ks = 0; ks < 4; ++ks) {
                const s16x4 lo = vtr(vp + d0 * 4096 + ks * 1024), hh = vtr(vp + d0 * 4096 + ks * 1024 + 512);
                o[d0] = __builtin_amdgcn_mfma_f32_32x32x16_bf16(VFRAG(lo, hh), __builtin_bit_cast(bf16x8, pw[ks]), o[d0], 0, 0, 0);
            }
        sl = (sl == 2) ? 0 : sl + 1;
    }
    l_reg = halfsum(l_reg);
    const float inv = 1.0f / l_reg;
    LAS unsigned char* stg = shm + LDS_OST + wid * OST_W;
#pragma unroll
    for (int d0 = 0; d0 < 2; ++d0)
#pragma unroll
        for (int rq = 0; rq < 4; ++rq) {
            u32x2 w; w.x = cvtpk(o[d0][4 * rq] * inv, o[d0][4 * rq + 1] * inv); w.y = cvtpk(o[d0][4 * rq + 2] * inv, o[d0][4 * rq + 3] * inv);
            *(LAS u32x2*)(stg + r32 * 144 + (32 * d0 + 8 * rq + 4 * hi) * 2) = w;
        }
    asm volatile("s_waitcnt lgkmcnt(0)" ::: "memory");
    bf16_t* Ow = MIX + (rowbase + q0 + wid * 32) * LD_MIX + 256 + h * 64;
#pragma unroll
    for (int i = 0; i < 4; ++i) { const int id = i * 64 + lane, row = id >> 3, ch = id & 7; const u32x4 v = *(const LAS u32x4*)(stg + row * 144 + ch * 16); *(u32x4*)(Ow + (long)row * LD_MIX + ch * 8) = v; }
    asm volatile("s_waitcnt lgkmcnt(0)\n\ts_barrier" ::: "memory");
#undef DMA_T
}

__device__ __forceinline__ void dil_task(int b, int hg, int c5, int r, const bf16_t* QKVA, bf16_t* MIX, LAS unsigned char* vl) {
    const int lane = threadIdx.x & 63, r32 = lane & 31, hi = lane >> 5;
    const long rowb = (long)b * SEQ;
    const int tq = 512 * c5 + r + 16 * r32;
    float m = -1e30f, l = 0.f; f32x16 o[2]; o[0] = f32x16{}; o[1] = f32x16{};
    const lds_cptr vp = (lds_cptr)vl + ((lane >> 4) & 1) * 32 + (lane & 3) * 8 + (4 * hi + ((lane & 15) >> 2)) * 64;
#pragma unroll 1
    for (int g = 0; g < 3; ++g) {
        const int sh = 2 * g, d = 1 << sh, sq = 16 >> sh, L = SEQ >> sh, nblk = (g == 0) ? 20 : (g == 1 ? 8 : 5), head = 4 * g + hg;
        const int rho = r & (d - 1), lq0 = (512 * c5 + r - rho) >> sh, lk0 = lq0 - 64, lq = lq0 + sq * r32;
        const bf16_t* Kb = QKVA + 768 + head * 64 + hi * 8;
        const bf16_t* Vb = QKVA + 1536 + head * 64;
        bf16x8 qf[4];
#pragma unroll
        for (int d0 = 0; d0 < 4; ++d0) qf[d0] = *(const bf16x8*)(QKVA + (rowb + tq) * LD_QKVA + head * 64 + d0 * 16 + hi * 8);
        bf16x8 kf[4]; u32x4 vv[4];
#define DIL_LOAD(kb) do { int lk = lk0 + 32 * (kb) + r32; lk = lk < 0 ? 0 : (lk > L - 1 ? L - 1 : lk); const bf16_t* kr = Kb + (rowb + (long)lk * d + rho) * LD_QKVA; \
            _Pragma("unroll") for (int d0 = 0; d0 < 4; ++d0) kf[d0] = *(const bf16x8*)(kr + d0 * 16); \
            _Pragma("unroll") for (int ii = 0; ii < 4; ++ii) { const int id = ii * 64 + lane, key = id >> 3, c8 = id & 7; int lv = lk0 + 32 * (kb) + key; lv = lv < 0 ? 0 : (lv > L - 1 ? L - 1 : lv); \
                vv[ii] = *(const u32x4*)(Vb + (rowb + (long)lv * d + rho) * LD_QKVA + c8 * 8); } } while (0)
        DIL_LOAD(0);
#pragma unroll 1
        for (int kb = 0; kb < nblk; ++kb) {
#pragma unroll
            for (int ii = 0; ii < 4; ++ii) { const int id = ii * 64 + lane, key = id >> 3, c8 = id & 7; *(LAS u32x4*)(vl + ((c8 >> 2) * 2 + (key >> 4)) * 1024 + (key & 15) * 64 + (c8 & 3) * 16) = vv[ii]; }
            f32x16 C = f32x16{};
#pragma unroll
            for (int d0 = 0; d0 < 4; ++d0) C = __builtin_amdgcn_mfma_f32_32x32x16_bf16(kf[d0], qf[d0], C, 0, 0, 0);
            if (kb + 1 < nblk) DIL_LOAD(kb + 1);
            const int kbase = lk0 + 32 * kb;
            float rm = -INFINITY;
#pragma unroll
            for (int rr = 0; rr < 16; ++rr) { const int lk = kbase + crow(rr, hi); const int df = lq - lk; const bool ok = (lk >= 0) && (lk < L) && (df <= 64) && (df >= -64); C[rr] = ok ? C[rr] : -INFINITY; rm = fmaxf(rm, C[rr]); }
            rm = halfmax(rm);
            const float mn = fmaxf(m, rm), f = __builtin_amdgcn_exp2f(m - mn); m = mn; l *= f;
#pragma unroll
            for (int rr = 0; rr < 16; ++rr) { o[0][rr] *= f; o[1][rr] *= f; }
            float sacc = 0.f;
#pragma unroll
            for (int rr = 0; rr < 16; ++rr) { C[rr] = __builtin_amdgcn_exp2f(C[rr] - mn); sacc += C[rr]; }
            l += sacc;
            u32x4 pw[2];
#pragma unroll
            for (int k = 0; k < 4; ++k) { pw[0][k] = cvtpk(C[2 * k], C[2 * k + 1]); pw[1][k] = cvtpk(C[8 + 2 * k], C[9 + 2 * k]); }
#pragma unroll
            for (int d0 = 0; d0 < 2; ++d0)
#pragma unroll
                for (int ks = 0; ks < 2; ++ks) {
                    const s16x4 lo = vtr(vp + d0 * 2048 + ks * 1024), hh = vtr(vp + d0 * 2048 + ks * 1024 + 512);
                    o[d0] = __builtin_amdgcn_mfma_f32_32x32x16_bf16(VFRAG(lo, hh), __builtin_bit_cast(bf16x8, pw[ks]), o[d0], 0, 0, 0);
                }
        }
#undef DIL_LOAD
    }
    l = halfsum(l);
    const float inv = 1.0f / l;
    bf16_t* Ow = MIX + (rowb + tq) * LD_MIX + hg * 64;
#pragma unroll
    for (int d0 = 0; d0 < 2; ++d0)
#pragma unroll
        for (int rq = 0; rq < 4; ++rq) {
            u32x2 w; w.x = cvtpk(o[d0][4 * rq] * inv, o[d0][4 * rq + 1] * inv); w.y = cvtpk(o[d0][4 * rq + 2] * inv, o[d0][4 * rq + 3] * inv);
            *(u32x2*)(Ow + 32 * d0 + 8 * rq + 4 * hi) = w;
        }
}
#undef WAIT_BAR
#undef VFRAG
}

constexpr int NWAVES = 8;
constexpr int RING_OFF = 0, RING_BYTES = 131072;
constexpr int LDSCTL_OFF = RING_BYTES, MISC_OFF = LDSCTL_OFF + 320;
constexpr int LDS_BYTES = 147456;
constexpr int CW_BAR = 4096;
constexpr int N_PHASES = 10;
constexpr int N_LAUNCHES = MK_N_LAUNCHES;

#define XB_TMO      128
#define XB_XCNT(j)  (256  + 64 * (j))
#define XB_XSUB(j)  (1280 + 64 * (j))
#define XB_XGEN(j)  (2304 + 64 * (j))
#define XB_TOP      3328
#define XB_TOPGEN   3392
#define XCD_BAR_WORDS 3456
#define XB_SPIN_CAP (1u << 18)
static_assert((CW_BAR + XCD_BAR_WORDS) * 4 <= (int)CTL_ZERO_BYTES, "ctl");
__device__ __forceinline__ unsigned xb_ld(unsigned* p)              { return __hip_atomic_load(p, __ATOMIC_RELAXED, __HIP_MEMORY_SCOPE_AGENT); }
__device__ __forceinline__ unsigned xb_add(unsigned* p, unsigned v) { return __hip_atomic_fetch_add(p, v, __ATOMIC_RELAXED, __HIP_MEMORY_SCOPE_AGENT); }
__device__ __forceinline__ unsigned xb_xcc_id() { return (unsigned)__builtin_amdgcn_s_getreg((3 << 11) | 20) & 0xFu; }
#define XB_SPIN(cond, bar) do { unsigned _sp = 0; while (cond) { __builtin_amdgcn_s_sleep(1); \
    if ((++_sp & 255u) == 0u) { if (xb_ld(&(bar)[XB_TMO])) break; if (_sp > XB_SPIN_CAP) { atomicAdd(&(bar)[XB_TMO], 1u); break; } } } } while (0)
struct XcdBarrier { unsigned* bar; unsigned x; volatile LAS unsigned* st; };
__device__ __forceinline__ XcdBarrier xcd_barrier_post(unsigned* bar, volatile LAS unsigned* st) {
    XcdBarrier b; b.bar = bar; b.x = xb_xcc_id(); b.st = st;
    if (threadIdx.x == 0) (void)xb_add(&bar[XB_XCNT(b.x)], 1u);
    return b;
}
__device__ __forceinline__ void xcd_barrier_complete(unsigned* bar, unsigned x, unsigned& nloc, unsigned& nx) {
    const unsigned G = gridDim.x * gridDim.y * gridDim.z;
    unsigned sum, cnt, mine, sp = 0u;
    for (;;) {
        sum = 0u; cnt = 0u; mine = 0u;
#pragma unroll
        for (unsigned j = 0; j < 16; ++j) { const unsigned c = xb_ld(&bar[XB_XCNT(j)]); sum += c; cnt += (c > 0u) ? 1u : 0u; mine = (j == x) ? c : mine; }
        if (sum == G) break;
        __builtin_amdgcn_s_sleep(1);
        if ((++sp & 255u) == 0u) { if (xb_ld(&bar[XB_TMO])) break; if (sp > XB_SPIN_CAP) { atomicAdd(&bar[XB_TMO], 1u); break; } }
    }
    nloc = mine > 0u ? mine : 1u; nx = cnt > 0u ? cnt : 1u;
}
__device__ __forceinline__ void xcd_barrier(const XcdBarrier& b) {
    asm volatile("s_waitcnt vmcnt(0)" ::: "memory");
    __syncthreads();
    if (threadIdx.x == 0) {
        unsigned* bar = b.bar;
        __builtin_amdgcn_s_waitcnt(0);
        unsigned nloc = b.st[0], nx = b.st[1];
        if (nloc == 0u) { xcd_barrier_complete(bar, b.x, nloc, nx); b.st[0] = nloc; b.st[1] = nx; }
        const unsigned old = xb_add(&bar[XB_XSUB(b.x)], 1u);
        const unsigned gen = old / nloc;
        if (old + 1u == (gen + 1u) * nloc) {
            __builtin_amdgcn_fence(__ATOMIC_RELEASE, "agent");
            asm volatile("s_waitcnt vmcnt(0)" ::: "memory");
            const unsigned og = xb_add(&bar[XB_TOP], 1u);
            const unsigned tg = og / nx;
            if (og + 1u == (tg + 1u) * nx) xb_add(&bar[XB_TOPGEN], 1u);
            else XB_SPIN(xb_ld(&bar[XB_TOPGEN]) == tg, bar);
            __builtin_amdgcn_fence(__ATOMIC_ACQUIRE, "agent");
            xb_add(&bar[XB_XGEN(b.x)], 1u);
            asm volatile("s_waitcnt vmcnt(0)" ::: "memory");
        } else {
            XB_SPIN(xb_ld(&bar[XB_XGEN(b.x)]) == gen, bar);
            __builtin_amdgcn_fence(__ATOMIC_ACQUIRE, "agent");
            asm volatile("s_waitcnt vmcnt(0)" ::: "memory");
        }
    }
    __syncthreads();
}

__device__ __forceinline__ unsigned f2bf(float f) { unsigned u = __builtin_bit_cast(unsigned, f); return (u + 0x7fffu + ((u >> 16) & 1u)) >> 16; }
__device__ __forceinline__ unsigned pk2(float lo, float hi) { return f2bf(lo) | (f2bf(hi) << 16); }
__device__ __forceinline__ float wave_sum(float v) {
#pragma unroll
    for (int o = 1; o < 64; o <<= 1) v += __shfl_xor(v, o);
    return v;
}
__device__ __forceinline__ void transpose_item(const float* W, int N, bf16_t* WT, int ldk, int koff, int drow0, const float* kgain, LAS float* scr, int k0, int n0, int lane) {
#pragma unroll 8
    for (int i = 0; i < 32; ++i) { const int kk = 2 * i + (lane >> 5); float w = W[(size_t)(k0 + kk) * N + n0 + (lane & 31)]; if (kgain) w *= kgain[k0 + kk]; scr[kk * 33 + (lane & 31)] = w; }
    asm volatile("s_waitcnt lgkmcnt(0)" ::: "memory");
    const int c = lane & 7;
#pragma unroll
    for (int j = 0; j < 4; ++j) { const int n = (lane >> 3) + 8 * j; const LAS float* s = scr + (8 * c) * 33 + n;
        u32x4 o; o.x = pk2(s[0 * 33], s[1 * 33]); o.y = pk2(s[2 * 33], s[3 * 33]); o.z = pk2(s[4 * 33], s[5 * 33]); o.w = pk2(s[6 * 33], s[7 * 33]);
        *(u32x4*)(WT + (size_t)(drow0 + n) * ldk + koff + k0 + 8 * c) = o; }
    asm volatile("s_waitcnt lgkmcnt(0)" ::: "memory");
}

struct Args {
    const float* in[16]; float* out; unsigned char* ws;
    float invA[8]; float invB[16];
    int ph_lo, ph_hi;
};

__global__ void __launch_bounds__(NWAVES * 64, 2) mega_fwd(Args args) {
    extern __shared__ __attribute__((aligned(16))) unsigned char lds_raw[];
    LAS unsigned char* lds = (LAS unsigned char*)lds_raw;
    volatile LAS unsigned* MISC = (volatile LAS unsigned*)(lds + MISC_OFF);
    const int tid = threadIdx.x, lane = tid & 63, wave = __builtin_amdgcn_readfirstlane(tid >> 6);
    const int G = gridDim.x; const int bx = blockIdx.x;
    const int vcu = (G % 8 == 0) ? (bx % 8) * (G / 8) + bx / 8 : bx;
    unsigned char* ws = args.ws;
    const float* x = args.in[0];
    float* out = args.out;
    bf16_t* Win_t = (bf16_t*)(ws + WS_WIN); bf16_t* Wuq_t = (bf16_t*)(ws + WS_WUQ); bf16_t* Wukv_t = (bf16_t*)(ws + WS_WUKV); bf16_t* Wo_t = (bf16_t*)(ws + WS_WO);
    bf16_t* Wout_t = (bf16_t*)(ws + WS_WOUT); bf16_t* Wf1_t = (bf16_t*)(ws + WS_WF1); bf16_t* Wf2_t = (bf16_t*)(ws + WS_WF2);
    float* CSA = (float*)(ws + WS_CSA); float* CSB = (float*)(ws + WS_CSB); float* SSQ = (float*)(ws + WS_SSQ);
    bf16_t* XN = (bf16_t*)(ws + WS_XN); bf16_t* MKV = XN; bf16_t* HN = (bf16_t*)(ws + WS_HN);
    bf16_t* QKVA = (bf16_t*)(ws + WS_QKVA); bf16_t* QC = (bf16_t*)(ws + WS_QC); bf16_t* KVC = (bf16_t*)(ws + WS_KVC); bf16_t* KPE = (bf16_t*)(ws + WS_KPE);
    bf16_t* MQ = (bf16_t*)(ws + WS_MQ); bf16_t* MIX = (bf16_t*)(ws + WS_MIX); bf16_t* U = (bf16_t*)(ws + WS_U); bf16_t* HID = (bf16_t*)(ws + WS_HID);
    float* MIXF = (float*)(ws + WS_F32); float* FFO = (float*)(ws + WS_FFO);
    bf16_t* GATES = (bf16_t*)out;

    for (int u = tid; u < (LDS_BYTES - LDSCTL_OFF) / 4; u += NWAVES * 64) ((LAS unsigned*)(lds + LDSCTL_OFF))[u] = 0u;
    __syncthreads();
    XcdBarrier bar; bar.bar = (unsigned*)(ws + WS_CTL) + CW_BAR; bar.x = 0; bar.st = nullptr;
    if (N_LAUNCHES == 1) bar = xcd_barrier_post((unsigned*)(ws + WS_CTL) + CW_BAR, MISC + 8);
    const int lo = args.ph_lo, hi_ph = args.ph_hi;
#ifndef PH_MASK
#define PH_MASK 0x3ff
#endif
#define IN(k) (((PH_MASK >> (k)) & 1) && lo <= (k) && (k) < hi_ph)
#define SEAM(k) do { if (IN(k) && IN((k) + 1)) xcd_barrier(bar); } while (0)
    const int gw = vcu * NWAVES + wave, NGW = G * NWAVES;

    if (IN(0)) {
        LAS float* scr = (LAS float*)(lds + RING_OFF + wave * 16384);
        constexpr int I_IN = (1024 / 64) * (IN_TOTAL / 32), I_UQ = (512 / 64) * (768 / 32), I_UKV = (256 / 64) * (1024 / 32), I_OA = (256 / 64) * (1024 / 32), I_OB = (512 / 64) * (1024 / 32),
                      I_OUT = (1024 / 64) * (1024 / 32), I_F1 = (1024 / 64) * (4096 / 32), I_F2 = (4096 / 64) * (1024 / 32);
        constexpr int NITEMS = I_IN + I_UQ + I_UKV + I_OA + I_OB + I_OUT + I_F1 + I_F2;
        for (int it = gw; it < NITEMS; it += NGW) {
            int r = it;
            if (r < I_IN) { const int nblk = IN_TOTAL / 32, kb = r / nblk, nb = r % nblk, n0 = 32 * nb;
                int dshift = 0; if (n0 >= 3072 && n0 < 3104) dshift = 5120 - 3072; else if (n0 >= 3104) dshift = -32;
                transpose_item(args.in[2], IN_TOTAL, Win_t, 1024, 0, n0 + dshift, nullptr, scr, 64 * kb, n0, lane); continue; } r -= I_IN;
            if (r < I_UQ) { const int nblk = 768 / 32; transpose_item(args.in[5], 768, Wuq_t, 512, 0, 32 * (r % nblk), args.in[4], scr, 64 * (r / nblk), 32 * (r % nblk), lane); continue; } r -= I_UQ;
            if (r < I_UKV) { const int nblk = 1024 / 32; transpose_item(args.in[7], 1024, Wukv_t, 256, 0, 32 * (r % nblk), args.in[6], scr, 64 * (r / nblk), 32 * (r % nblk), lane); continue; } r -= I_UKV;
            if (r < I_OA) { const int nblk = 1024 / 32; transpose_item(args.in[8], 1024, Wo_t, 768, 0, 32 * (r % nblk), nullptr, scr, 64 * (r / nblk), 32 * (r % nblk), lane); continue; } r -= I_OA;
            if (r < I_OB) { const int nblk = 1024 / 32; transpose_item(args.in[9], 1024, Wo_t, 768, 256, 32 * (r % nblk), nullptr, scr, 64 * (r / nblk), 32 * (r % nblk), lane); continue; } r -= I_OB;
            if (r < I_OUT) { const int nblk = 1024 / 32; transpose_item(args.in[10], 1024, Wout_t, 1024, 0, 32 * (r % nblk), nullptr, scr, 64 * (r / nblk), 32 * (r % nblk), lane); continue; } r -= I_OUT;
            if (r < I_F1) { const int nblk = 4096 / 32; transpose_item(args.in[13], 4096, Wf1_t, 1024, 0, 32 * (r % nblk), nullptr, scr, 64 * (r / nblk), 32 * (r % nblk), lane); continue; } r -= I_F1;
            { const int nblk = 1024 / 32; transpose_item(args.in[14], 1024, Wf2_t, 4096, 0, 32 * (r % nblk), nullptr, scr, 64 * (r / nblk), 32 * (r % nblk), lane); }
        }
        for (int i = gw * 64 + lane; i < (NPROJ - IN_TOTAL) * 1024 / 8; i += NGW * 64) ((u32x4*)(Win_t + (size_t)IN_TOTAL * 1024))[i] = (u32x4){0u, 0u, 0u, 0u};
        for (int i = gw * 64 + lane; i < SEQ * 24; i += NGW * 64) {
            const int pos = i / 24, j = i % 24; const float inv = (j < 8) ? args.invA[j] : args.invB[j - 8];
            const float ang = (float)pos * inv; double rev = (double)ang * 0.15915494309189535; rev -= __builtin_floor(rev); const float fr = (float)rev;
            const float c = __builtin_amdgcn_cosf(fr), s = __builtin_amdgcn_sinf(fr);
            if (j < 8) { CSA[pos * 16 + j] = c; CSA[pos * 16 + 8 + j] = s; } else { CSB[pos * 32 + (j - 8)] = c; CSB[pos * 32 + 16 + (j - 8)] = s; }
        }
        const float* gpre = args.in[1];
        for (int m = gw; m < M; m += NGW) {
            const f32x4* xr = (const f32x4*)(x + (size_t)m * DM) + lane; f32x4 v[4]; float s = 0.f;
#pragma unroll
            for (int j = 0; j < 4; ++j) { v[j] = xr[64 * j]; s += (v[j].x * v[j].x + v[j].y * v[j].y) + (v[j].z * v[j].z + v[j].w * v[j].w); }
            const float rstd = __builtin_amdgcn_rsqf(wave_sum(s) * (1.f / DM) + EPS);
            unsigned long long* o8 = (unsigned long long*)(XN + (size_t)m * DM) + lane;
#pragma unroll
            for (int j = 0; j < 4; ++j) { const f32x4 gg = ((const f32x4*)gpre)[lane + 64 * j];
                o8[64 * j] = (unsigned long long)pk2(v[j].x * rstd * gg.x, v[j].y * rstd * gg.y) | ((unsigned long long)pk2(v[j].z * rstd * gg.z, v[j].w * rstd * gg.w) << 32); }
        }
    }
    SEAM(0);
    if (IN(1)) {
        pg8::Gemm g{XN, Win_t, 1024, 1024, 1024}; pg8::StaticOrder S; S.init(M, NPROJ, G, bx);
        pg8::Epi<0> E; E.a = pg8::EpiArgs{QKVA, QC, KVC, GATES, KPE, nullptr, SSQ, args.in[3], CSA, CSB, nullptr};
        pg8::gemm_phase(lds + RING_OFF, g, S, E);
    }
    SEAM(1);
    if (IN(2)) {
        { pg8::Gemm g{QC, Wuq_t, LD_QC, 512, 512}; pg8::StaticOrder S; S.init(M, 768, G, bx);
          pg8::Epi<1> E; E.a = pg8::EpiArgs{MQ, nullptr, nullptr, nullptr, nullptr, nullptr, SSQ, nullptr, CSA, CSB, nullptr};
          pg8::gemm_phase(lds + RING_OFF, g, S, E); }
        { pg8::Gemm g{KVC, Wukv_t, LD_KVC, 256, 256}; pg8::StaticOrder S; S.init(M, 1024, G, bx);
          pg8::Epi<2> E; E.a = pg8::EpiArgs{MKV, nullptr, nullptr, nullptr, nullptr, nullptr, SSQ, nullptr, CSA, CSB, nullptr};
          pg8::gemm_phase(lds + RING_OFF, g, S, E); }
    }
    SEAM(2);
    if (IN(3)) {
        {
            for (int task = gw; task < 2048; task += NGW) {
                const int cu = task >> 3, w = task & 7;
                att::dil_task(cu >> 7, (cu >> 1) & 3, (cu >> 3) & 15, ((cu & 1) << 3) | w, QKVA, MIX, lds + RING_OFF + wave * 4096);
            }
        }
        asm volatile("s_waitcnt vmcnt(0) lgkmcnt(0)" ::: "memory");
        __syncthreads();
        for (int uix = vcu; uix < 512; uix += G) {
            att::mla_unit((uix >> 5) >> 3, (uix >> 5) & 7, uix & 31, MQ, MKV, KPE, MIX, lds + RING_OFF);
        }
    }
    SEAM(3);
    if (IN(4)) {
        { pg8::Gemm g{MIX, Wo_t, LD_MIX, 768, 256}; pg8::StaticOrder S; S.init(M, 1024, G, bx);
          pg8::Epi<3> E; E.a = pg8::EpiArgs{U, nullptr, nullptr, nullptr, nullptr, nullptr, nullptr, nullptr, nullptr, nullptr, GATES};
          pg8::gemm_phase(lds + RING_OFF, g, S, E); }
        asm volatile("s_waitcnt vmcnt(0)" ::: "memory"); __syncthreads();
        { pg8::Gemm g{MIX + 256, Wo_t + 256, LD_MIX, 768, 512}; pg8::StaticOrder S; S.init(M, 1024, G, bx);
          pg8::Epi<4> E; E.a = pg8::EpiArgs{U, nullptr, nullptr, nullptr, nullptr, nullptr, nullptr, nullptr, nullptr, nullptr, GATES};
          pg8::gemm_phase(lds + RING_OFF, g, S, E); }
    }
    SEAM(4);
    if (IN(5)) {
        pg8::Gemm g{U, Wout_t, 1024, 1024, 1024}; pg8::StaticOrder S; S.init(M, 1024, G, bx);
        pg8::Epi<5> E; E.a = pg8::EpiArgs{nullptr, nullptr, nullptr, nullptr, nullptr, MIXF, SSQ, nullptr, nullptr, nullptr, nullptr};
        pg8::gemm_phase(lds + RING_OFF, g, S, E);
    }
    SEAM(5);
    if (IN(6)) {
        const float* gpost = args.in[11]; const float* gmlp = args.in[12];
        for (int m = gw; m < M; m += NGW) {
            float ss = 0.f; { const f32x4* sp = (const f32x4*)(SSQ + (size_t)m * 16);
#pragma unroll
                for (int j = 0; j < 4; ++j) { const f32x4 t = sp[j]; ss += (t.x + t.y) + (t.z + t.w); } }
            const float r1 = __builtin_amdgcn_rsqf(ss * (1.f / DM) + EPS);
            const f32x4* xr = (const f32x4*)(x + (size_t)m * DM) + lane; const f32x4* mr = (const f32x4*)(MIXF + (size_t)m * DM) + lane; f32x4* hr = (f32x4*)(out + (size_t)m * DM) + lane;
            f32x4 hv[4]; float s = 0.f;
#pragma unroll
            for (int j = 0; j < 4; ++j) { const f32x4 gg = ((const f32x4*)gpost)[lane + 64 * j]; hv[j] = xr[64 * j] + mr[64 * j] * r1 * gg; hr[64 * j] = hv[j]; s += (hv[j].x * hv[j].x + hv[j].y * hv[j].y) + (hv[j].z * hv[j].z + hv[j].w * hv[j].w); }
            const float r2 = __builtin_amdgcn_rsqf(wave_sum(s) * (1.f / DM) + EPS);
            unsigned long long* o8 = (unsigned long long*)(HN + (size_t)m * DM) + lane;
#pragma unroll
            for (int j = 0; j < 4; ++j) { const f32x4 gg = ((const f32x4*)gmlp)[lane + 64 * j];
                o8[64 * j] = (unsigned long long)pk2(hv[j].x * r2 * gg.x, hv[j].y * r2 * gg.y) | ((unsigned long long)pk2(hv[j].z * r2 * gg.z, hv[j].w * r2 * gg.w) << 32); }
        }
    }
    SEAM(6);
    if (IN(7)) {
        pg8::Gemm g{HN, Wf1_t, 1024, 1024, 1024}; pg8::StaticOrder S; S.init(M, FF, G, bx);
        pg8::Epi<6> E; E.a = pg8::EpiArgs{HID, nullptr, nullptr, nullptr, nullptr, nullptr, nullptr, nullptr, nullptr, nullptr, nullptr};
        pg8::gemm_phase(lds + RING_OFF, g, S, E);
    }
    SEAM(7);
    if (IN(8)) {
        pg8::Gemm g{HID, Wf2_t, FF, FF, FF}; pg8::StaticOrder S; S.init(M, 1024, G, bx);
        pg8::Epi<5> E; E.a = pg8::EpiArgs{nullptr, nullptr, nullptr, nullptr, nullptr, FFO, SSQ, nullptr, nullptr, nullptr, nullptr};
        pg8::gemm_phase(lds + RING_OFF, g, S, E);
    }
    SEAM(8);
    if (IN(9)) {
        const float* gp = args.in[15];
        for (int m = gw; m < M; m += NGW) {
            float ss = 0.f; { const f32x4* sp = (const f32x4*)(SSQ + (size_t)m * 16);
#pragma unroll
                for (int j = 0; j < 4; ++j) { const f32x4 t = sp[j]; ss += (t.x + t.y) + (t.z + t.w); } }
            const float r1 = __builtin_amdgcn_rsqf(ss * (1.f / DM) + EPS);
            const f32x4* fr = (const f32x4*)(FFO + (size_t)m * DM) + lane; f32x4* hr = (f32x4*)(out + (size_t)m * DM) + lane;
#pragma unroll
            for (int j = 0; j < 4; ++j) { const f32x4 gg = ((const f32x4*)gp)[lane + 64 * j]; hr[64 * j] = hr[64 * j] + fr[64 * j] * r1 * gg; }
        }
    }
#undef IN
#undef SEAM
}

extern "C" void kernel_launch(void* const* d_in, const int* in_sizes, int n_in, void* d_out, int out_size, void* d_ws, size_t ws_size, hipStream_t stream) {
    static int grid = 0;
    if (grid == 0) {
        if (n_in != 16 || in_sizes[0] != M * DM || out_size != M * DM || ws_size < 256 * MiB) { fprintf(stderr, "kernel_launch: unexpected shapes (n_in %d, ws %zu)\n", n_in, ws_size); grid = -1; return; }
        int dev = 0, cus = 0, per_cu = 0;
        if (hipGetDevice(&dev) != hipSuccess || hipDeviceGetAttribute(&cus, hipDeviceAttributeMultiprocessorCount, dev) != hipSuccess) { grid = -1; return; }
        if (hipFuncSetAttribute((const void*)mega_fwd, hipFuncAttributeMaxDynamicSharedMemorySize, LDS_BYTES) != hipSuccess) { fprintf(stderr, "kernel_launch: hipFuncSetAttribute failed\n"); grid = -1; return; }
        if (hipOccupancyMaxActiveBlocksPerMultiprocessor(&per_cu, (const void*)mega_fwd, NWAVES * 64, LDS_BYTES) != hipSuccess || per_cu < 1) fprintf(stderr, "kernel_launch: occupancy query says %d\n", per_cu);
        (void)hipGetLastError();
        grid = cus;
    }
    if (grid < 0) return;
    (void)hipMemsetAsync((char*)d_ws + WS_CTL, 0, CTL_ZERO_BYTES, stream);
    Args a{};
    for (int i = 0; i < 16; ++i) a.in[i] = (const float*)d_in[i];
    a.out = (float*)d_out; a.ws = (unsigned char*)d_ws;
    for (int i = 0; i < 8; ++i) a.invA[i] = powf(500000.0f, -((float)i * 2.0f / 16.0f));
    for (int i = 0; i < 16; ++i) a.invB[i] = powf(10000.0f, -((float)i * 2.0f / 32.0f));
    if (N_LAUNCHES == 1) { a.ph_lo = 0; a.ph_hi = N_PHASES; hipLaunchKernelGGL(mega_fwd, dim3(grid), dim3(NWAVES * 64), LDS_BYTES, stream, a); }
    else for (int p = 0; p < N_PHASES; ++p) { a.ph_lo = p; a.ph_hi = p + 1; hipLaunchKernelGGL(mega_fwd, dim3(grid), dim3(NWAVES * 64), LDS_BYTES, stream, a); }
}
```

```cpp
#include <hip/hip_runtime.h>
#include <hip/hip_bf16.h>
#include <cstdio>
#include <cstdint>
#include <cmath>

#ifndef MK_N_LAUNCHES
#define MK_N_LAUNCHES 1
#endif

#define LAS __attribute__((address_space(3)))
#define GAS __attribute__((address_space(1)))
typedef unsigned short bf16_t;
typedef short bf16x8 __attribute__((ext_vector_type(8)));
typedef short s16x4 __attribute__((ext_vector_type(4)));
typedef float f32x4 __attribute__((ext_vector_type(4)));
typedef float f32x16 __attribute__((ext_vector_type(16)));
typedef unsigned u32x4 __attribute__((ext_vector_type(4)));
typedef unsigned u32x2 __attribute__((ext_vector_type(2)));
typedef float f32x2_t __attribute__((ext_vector_type(2)));
typedef __bf16 bf16x2_t __attribute__((ext_vector_type(2)));

constexpr int SEQ = 8192, NB = 2, M = NB * SEQ, DM = 1024, FF = 4096;
constexpr int IN_TOTAL = 5152;
constexpr int NPROJ = 5376;
constexpr int LD_QKVA = 2304, LD_QC = 512, LD_KVC = 256, LD_G = 2048, LD_KPE = 32, LD_MQ = 768, LD_MKV = 1024, LD_MIX = 768;
constexpr float EPS = 1e-6f;
constexpr float LOG2E = 1.4426950408889634f;
constexpr float QSCALE_A = 0.125f * LOG2E;
constexpr float QSCALE_B = 0.10206207261596577f * LOG2E;

constexpr size_t MiB = 1u << 20;
constexpr size_t WS_CTL = 0, CTL_ZERO_BYTES = 64 * 1024;
constexpr size_t WS_WIN = 256 * 1024;
constexpr size_t WS_WUQ = WS_WIN + (size_t)NPROJ * 1024 * 2;
constexpr size_t WS_WUKV = WS_WUQ + (size_t)768 * 512 * 2;
constexpr size_t WS_WO = WS_WUKV + (size_t)1024 * 256 * 2;
constexpr size_t WS_WOUT = WS_WO + (size_t)1024 * 768 * 2;
constexpr size_t WS_WF1 = WS_WOUT + (size_t)1024 * 1024 * 2;
constexpr size_t WS_WF2 = WS_WF1 + (size_t)4096 * 1024 * 2;
constexpr size_t WS_CSA = WS_WF2 + (size_t)4096 * 1024 * 2;
constexpr size_t WS_CSB = WS_CSA + (size_t)8192 * 16 * 4;
constexpr size_t WS_SSQ = WS_CSB + (size_t)8192 * 32 * 4;
constexpr size_t WS_WEND = WS_SSQ + (size_t)M * 16 * 4;
static_assert(WS_WEND <= 34 * MiB, "weights region");
constexpr size_t WS_XN = 34 * MiB;
constexpr size_t WS_QKVA = 66 * MiB;
constexpr size_t WS_QC = 138 * MiB;
constexpr size_t WS_KVC = 154 * MiB;
constexpr size_t WS_KPE = 162 * MiB;
constexpr size_t WS_MQ = 163 * MiB;
constexpr size_t WS_MIX = 187 * MiB;
constexpr size_t WS_U = 211 * MiB;
constexpr size_t WS_F32 = 66 * MiB;
constexpr size_t WS_HN = 224 * MiB;
constexpr size_t WS_HID = 34 * MiB;
constexpr size_t WS_FFO = 162 * MiB;
static_assert(WS_U + (size_t)M * 1024 * 2 <= 256 * MiB && WS_HN + (size_t)M * 1024 * 2 <= 256 * MiB, "ws");

namespace pg8 {
constexpr int BM = 256, BK = 64, HALF = 128, HTB = HALF * BK * 2, STAGE_BYTES = 8 * HTB, NXCD = 8, WGM = 8;
__host__ __device__ __forceinline__ int lds_byte(int r, int c) { const int st = (r >> 4) * 2 + (c >> 5), rr = r & 15, cc = c & 31, ob = rr * 64 + cc * 2; return st * 1024 + (ob ^ (((ob >> 9) & 1) << 5)); }
__host__ __device__ __forceinline__ void stage_rc(int b, int& R, int& C) { const int st = b / 1024, sb = b % 1024, swz = sb ^ (((sb >> 9) & 1) << 5); R = (st >> 1) * 16 + swz / 64; C = (st & 1) * 32 + (swz % 64) / 2; }
__host__ __device__ __forceinline__ int perm32(int rho) { const int n = rho >> 4, i = rho & 15; return 8 * (i >> 2) + 4 * n + (i & 3); }
struct Unit { int pm, pn; };
struct Gemm { const bf16_t* A; const bf16_t* Bt; int lda, ldb, K; };
struct StaticOrder {
    int nM, nN, nwg, G, c;
    __device__ void init(int M_, int N_, int G_, int c_) { nM = M_ / BM; nN = N_ / BM; nwg = nM * nN; G = G_; c = c_; }
    __device__ bool next(int i, Unit& u) const {
        const long L = (long)i * G + c; if (L >= nwg) return false;
        int wgid = (int)L; { const int q = nwg / NXCD, r = nwg % NXCD, xcd = wgid % NXCD, off = wgid / NXCD; wgid = (xcd < r ? xcd * (q + 1) : r * (q + 1) + (xcd - r) * q) + off; }
        const int nig = WGM * nN, gid = wgid / nig, fm = gid * WGM, gsz = (nM - fm) < WGM ? (nM - fm) : WGM;
        u.pm = fm + ((wgid % nig) % gsz); u.pn = (wgid % nig) / gsz; return true;
    }
};
__device__ __forceinline__ unsigned cvt_pk_bf16(float lo, float hi) { f32x2_t v = {lo, hi}; bf16x2_t b = __builtin_convertvector(v, bf16x2_t); return __builtin_bit_cast(unsigned, b); }
__device__ __forceinline__ float bf_lo(unsigned w) { return __uint_as_float(w << 16); }
__device__ __forceinline__ float bf_hi(unsigned w) { return __uint_as_float(w & 0xffff0000u); }

struct EpiArgs {
    bf16_t *o0, *o1, *o2, *o3, *o4;
    float* f0; float* ssq; const float* bias; const float* csa; const float* csb; const bf16_t* gates;
};
template <int MODE> struct Epi {
    static constexpr bool PERM = true;
    EpiArgs a;
    __device__ __forceinline__ void store8(bf16_t* p, const float (&v)[8]) const {
        u32x4 w; w.x = cvt_pk_bf16(v[0], v[1]); w.y = cvt_pk_bf16(v[2], v[3]); w.z = cvt_pk_bf16(v[4], v[5]); w.w = cvt_pk_bf16(v[6], v[7]); *(u32x4*)p = w;
    }
    __device__ __forceinline__ void operator()(const f32x4 (&acc)[2][2][4][2], const Unit& u, int wr, int wc, int fr, int fq) const {
        const int pn = u.pn;
#pragma unroll
        for (int ai = 0; ai < 2; ++ai)
#pragma unroll
            for (int m = 0; m < 4; ++m) {
                const int row = u.pm * BM + ai * HALF + wr * 64 + m * 16 + fr;
                const int pos = row & (SEQ - 1);
                float rs = 1.f;
                if (MODE == 1) { const f32x4 s0 = *(const f32x4*)(a.ssq + (size_t)row * 16), s1 = *(const f32x4*)(a.ssq + (size_t)row * 16 + 4);
                    const float s = ((s0[0] + s0[1]) + (s0[2] + s0[3])) + ((s1[0] + s1[1]) + (s1[2] + s1[3])); rs = __builtin_amdgcn_rsqf(s * (1.f / 512.f) + EPS) * QSCALE_B; }
                if (MODE == 2) { const f32x4 s0 = *(const f32x4*)(a.ssq + (size_t)row * 16 + 8); const float s = (s0[0] + s0[1]) + (s0[2] + s0[3]); rs = __builtin_amdgcn_rsqf(s * (1.f / 256.f) + EPS); }
                float sq = 0.f;
#pragma unroll
                for (int bj = 0; bj < 2; ++bj) {
                    const int ct = bj * HALF + wc * 32 + 8 * fq;
                    float v[8];
#pragma unroll
                    for (int j = 0; j < 4; ++j) { v[j] = acc[ai][bj][m][0][j]; v[4 + j] = acc[ai][bj][m][1][j]; }
                    if (MODE == 0) {
                        if (pn < 6) {
                            if ((wc & 1) == 0) {
                                float c[8], s[8];
                                if (fq < 2) {
#pragma unroll
                                    for (int j = 0; j < 8; j += 4) { const f32x4 cc = *(const f32x4*)(a.csa + pos * 16 + j), ss = *(const f32x4*)(a.csa + pos * 16 + 8 + j);
#pragma unroll
                                        for (int e = 0; e < 4; ++e) { c[j + e] = cc[e]; s[j + e] = ss[e]; } }
                                } else {
#pragma unroll
                                    for (int j = 0; j < 8; ++j) { c[j] = 1.f; s[j] = 0.f; }
                                }
                                const float sg = (fq == 0) ? -1.f : 1.f;
#pragma unroll
                                for (int j = 0; j < 8; ++j) { const float p = __shfl_xor(v[j], 16); v[j] = v[j] * c[j] + sg * p * s[j]; }
                            }
                            if (pn < 3) {
#pragma unroll
                                for (int j = 0; j < 8; ++j) v[j] *= QSCALE_A;
                            }
                            store8(a.o0 + (size_t)row * LD_QKVA + pn * BM + ct, v);
                        } else if (pn < 9) {
                            store8(a.o0 + (size_t)row * LD_QKVA + pn * BM + ct, v);
                        } else if (pn < 12) {
#pragma unroll
                            for (int j = 0; j < 8; ++j) sq += v[j] * v[j];
                            if (pn < 11) store8(a.o1 + (size_t)row * LD_QC + (pn - 9) * BM + ct, v);
                            else store8(a.o2 + (size_t)row * LD_KVC + ct, v);
                        } else if (pn < 20) {
                            const int gc = (pn - 12) * BM + ct;
                            const f32x4 b0 = *(const f32x4*)(a.bias + gc), b1 = *(const f32x4*)(a.bias + gc + 4);
#pragma unroll
                            for (int j = 0; j < 4; ++j) { v[j] = __builtin_amdgcn_rcpf(1.f + __builtin_amdgcn_exp2f(-(v[j] + b0[j]) * LOG2E)); v[4 + j] = __builtin_amdgcn_rcpf(1.f + __builtin_amdgcn_exp2f(-(v[4 + j] + b1[j]) * LOG2E)); }
                            store8(a.o3 + (size_t)row * LD_G + gc, v);
                        } else {
                            if (wc == 0 && bj == 0) {
                                const int fi = 8 * (fq & 1);
                                const float sg = (fq < 2) ? -1.f : 1.f;
#pragma unroll
                                for (int j = 0; j < 8; ++j) { const float p = __shfl_xor(v[j], 32); const float c = a.csb[pos * 32 + fi + j], s = a.csb[pos * 32 + 16 + fi + j]; v[j] = v[j] * c + sg * p * s; }
                                store8(a.o4 + (size_t)row * LD_KPE + 8 * fq, v);
                            }
                        }
                    } else if (MODE == 1) {
#pragma unroll
                        for (int j = 0; j < 8; ++j) v[j] *= rs;
                        const int g32 = 8 * pn + 4 * bj + wc;
                        if ((g32 % 3) == 2) {
                            const int fi = 8 * (fq & 1);
                            const float sg = (fq < 2) ? -1.f : 1.f;
#pragma unroll
                            for (int j = 0; j < 8; ++j) { const float p = __shfl_xor(v[j], 32); const float c = a.csb[pos * 32 + fi + j], s = a.csb[pos * 32 + 16 + fi + j]; v[j] = v[j] * c + sg * p * s; }
                        }
                        store8(a.o0 + (size_t)row * LD_MQ + pn * BM + ct, v);
                    } else if (MODE == 2) {
#pragma unroll
                        for (int j = 0; j < 8; ++j) v[j] *= rs;
                        store8(a.o0 + (size_t)row * LD_MKV + pn * BM + ct, v);
                    } else if (MODE == 3 || MODE == 4) {
                        const int col = pn * BM + ct;
                        const u32x4 g = *(const u32x4*)(a.gates + (size_t)row * LD_G + (MODE == 4 ? 1024 : 0) + col);
                        float gg[8] = {bf_lo(g.x), bf_hi(g.x), bf_lo(g.y), bf_hi(g.y), bf_lo(g.z), bf_hi(g.z), bf_lo(g.w), bf_hi(g.w)};
                        bf16_t* up = a.o0 + (size_t)row * 1024 + col;
                        if (MODE == 4) { const u32x4 o = *(const u32x4*)up; const float oo[8] = {bf_lo(o.x), bf_hi(o.x), bf_lo(o.y), bf_hi(o.y), bf_lo(o.z), bf_hi(o.z), bf_lo(o.w), bf_hi(o.w)};
#pragma unroll
                            for (int j = 0; j < 8; ++j) v[j] = oo[j] + gg[j] * v[j];
                        } else {
#pragma unroll
                            for (int j = 0; j < 8; ++j) v[j] = gg[j] * v[j];
                        }
                        store8(up, v);
                    } else if (MODE == 5) {
#pragma unroll
                        for (int j = 0; j < 8; ++j) sq += v[j] * v[j];
                        float* op = a.f0 + (size_t)row * 1024 + pn * BM + ct;
                        *(f32x4*)op = (f32x4){v[0], v[1], v[2], v[3]}; *(f32x4*)(op + 4) = (f32x4){v[4], v[5], v[6], v[7]};
                    } else if (MODE == 6) {
#pragma unroll
                        for (int j = 0; j < 8; ++j) { const float r = fmaxf(v[j], 0.f); v[j] = r * r; }
                        store8(a.o0 + (size_t)row * FF + pn * BM + ct, v);
                    }
                }
                if (MODE == 3 || MODE == 4) asm volatile("" ::: "memory");
                if (MODE == 5 || (MODE == 0 && pn >= 9 && pn < 12)) {
                    sq += __shfl_xor(sq, 16); sq += __shfl_xor(sq, 32);
                    const int slot = (MODE == 5) ? (pn * 4 + wc) : ((pn - 9) * 4 + wc);
                    if (fq == 0) a.ssq[(size_t)row * 16 + slot] = sq;
                }
            }
    }
};

template <class EpiT>
__device__ __forceinline__ void gemm_phase(LAS unsigned char* lds, const Gemm g, const StaticOrder& S, const EpiT& E) {
    const int tid = threadIdx.x, wid = __builtin_amdgcn_readfirstlane(tid >> 6), lane = tid & 63, wr = wid >> 2, wc = wid & 3, fr = lane & 15, fq = lane >> 4;
    int nt = g.K / BK; asm volatile("" : "+s"(nt));
    unsigned voffA[2], voffB[2];
#pragma unroll
    for (int i = 0; i < 2; ++i) { int R, C; stage_rc(tid * 16 + i * 8192, R, C); const int Rb = EpiT::PERM ? ((R & ~31) + perm32(R & 31)) : R;
        voffA[i] = (unsigned)(R * g.lda + C) * 2u; voffB[i] = (unsigned)(Rb * g.ldb + C) * 2u; }
    const size_t kstep = (size_t)(BK * 2);
    const size_t hstepA = (size_t)HALF * g.lda * 2, hstepB = (size_t)HALF * g.ldb * 2;
    const size_t tstepA = 2 * hstepA, tstepB = 2 * hstepB;
    const unsigned ldsw = (unsigned)wid * 1024u;
    const int aoff = lds_byte(wr * 64 + fr, fq * 8), boff = lds_byte(wc * 32 + fr, fq * 8);
#define PG8_SA(b, h) (((b) * 2 + (h)) * HTB)
#define PG8_SB(b, h) ((4 + (b) * 2 + (h)) * HTB)
#define PG8_STAGE(bufoff, gbase, voff) do { _Pragma("unroll") for (int _i = 0; _i < 2; ++_i) \
        __builtin_amdgcn_global_load_lds((const unsigned*)((const char*)(gbase) + (voff)[_i]), (LAS unsigned*)(lds + (bufoff) + ldsw + _i * 8192), 16, 0, 0); } while (0)
#define PG8_LDA(dst, b, h) do { _Pragma("unroll") for (int m = 0; m < 4; ++m) _Pragma("unroll") for (int k = 0; k < 2; ++k) dst[m][k] = *(const LAS bf16x8*)(lds + PG8_SA(b, h) + aoff + m * 2048 + k * 1024); } while (0)
#define PG8_LDB(dst, b, h) do { _Pragma("unroll") for (int n = 0; n < 2; ++n) _Pragma("unroll") for (int k = 0; k < 2; ++k) dst[n][k] = *(const LAS bf16x8*)(lds + PG8_SB(b, h) + boff + n * 2048 + k * 1024); } while (0)
#define PG8_MMA(ai, bj, At, Bt) do { __builtin_amdgcn_s_setprio(1); _Pragma("unroll") for (int m = 0; m < 4; ++m) _Pragma("unroll") for (int n = 0; n < 2; ++n) _Pragma("unroll") for (int k = 0; k < 2; ++k) \
        acc[ai][bj][m][n] = __builtin_amdgcn_mfma_f32_16x16x32_bf16(Bt[n][k], At[m][k], acc[ai][bj][m][n], 0, 0, 0); __builtin_amdgcn_s_setprio(0); } while (0)
#define PG8_WAIT_V(n) asm volatile("s_waitcnt vmcnt(" #n ")" ::: "memory")
#define PG8_WAIT_L(n) asm volatile("s_waitcnt lgkmcnt(" #n ")" ::: "memory")
#define PG8_BAR __builtin_amdgcn_s_barrier()
#define PG8_SCHED __builtin_amdgcn_sched_barrier(0)
    Unit cur, nxt; int ui = 0;
    if (!S.next(0, cur)) return;
    f32x4 acc[2][2][4][2];
#pragma unroll
    for (int a = 0; a < 2; ++a)
#pragma unroll
        for (int b = 0; b < 2; ++b)
#pragma unroll
            for (int m = 0; m < 4; ++m)
#pragma unroll
                for (int n = 0; n < 2; ++n) acc[a][b][m][n] = (f32x4){0.f, 0.f, 0.f, 0.f};
    bf16x8 At[4][2], B0[2][2], B1[2][2];
    const char* cA = (const char*)g.A + (size_t)cur.pm * tstepA; const char* cB = (const char*)g.Bt + (size_t)cur.pn * tstepB;
    PG8_STAGE(PG8_SB(0, 0), cB, voffB); PG8_STAGE(PG8_SB(0, 1), cB + hstepB, voffB); PG8_STAGE(PG8_SA(0, 0), cA, voffA); PG8_STAGE(PG8_SA(0, 1), cA + hstepA, voffA);
    if (wr == 1) PG8_BAR;
    PG8_WAIT_V(2); PG8_BAR;
    PG8_STAGE(PG8_SB(1, 0), cB + kstep, voffB); PG8_STAGE(PG8_SA(1, 0), cA + kstep, voffA); PG8_STAGE(PG8_SB(1, 1), cB + hstepB + kstep, voffB);
    PG8_WAIT_V(6); PG8_BAR;
    for (;;) {
        const bool has_next = S.next(ui + 1, nxt);
        const char* nA = has_next ? (const char*)g.A + (size_t)nxt.pm * tstepA : cA; const char* nB = has_next ? (const char*)g.Bt + (size_t)nxt.pn * tstepB : cB;
        for (int t = 0; t < nt; t += 2) {
            const bool last = (t == nt - 2);
            const char* a1 = cA + (size_t)(t + 1) * kstep;
            const char* a2 = last ? nA : cA + (size_t)(t + 2) * kstep; const char* b2 = last ? nB : cB + (size_t)(t + 2) * kstep;
            const char* a3 = a2 + kstep; const char* b3 = b2 + kstep;
            PG8_LDB(B0, 0, 0); PG8_LDB(B1, 0, 1); PG8_SCHED; PG8_LDA(At, 0, 0); PG8_STAGE(PG8_SA(1, 1), a1 + hstepA, voffA);
            PG8_WAIT_V(8); PG8_WAIT_L(0); PG8_BAR; PG8_MMA(0, 0, At, B0); PG8_MMA(0, 1, At, B1); PG8_BAR; PG8_SCHED;
            PG8_LDA(At, 0, 1); PG8_STAGE(PG8_SB(0, 0), b2, voffB); PG8_STAGE(PG8_SB(0, 1), b2 + hstepB, voffB); PG8_STAGE(PG8_SA(0, 0), a2, voffA);
            PG8_WAIT_V(8); PG8_WAIT_L(0); PG8_BAR; PG8_MMA(1, 0, At, B0); PG8_MMA(1, 1, At, B1); PG8_BAR; PG8_SCHED;
            PG8_LDB(B0, 1, 0); PG8_LDB(B1, 1, 1); PG8_SCHED; PG8_LDA(At, 1, 0); PG8_STAGE(PG8_SA(0, 1), a2 + hstepA, voffA);
            PG8_WAIT_V(8); PG8_WAIT_L(0); PG8_BAR; PG8_MMA(0, 0, At, B0); PG8_MMA(0, 1, At, B1); PG8_BAR; PG8_SCHED;
            PG8_LDA(At, 1, 1); PG8_STAGE(PG8_SB(1, 0), b3, voffB); PG8_STAGE(PG8_SB(1, 1), b3 + hstepB, voffB); PG8_STAGE(PG8_SA(1, 0), a3, voffA);
            PG8_WAIT_V(8); PG8_WAIT_L(0); PG8_BAR; PG8_MMA(1, 0, At, B0); PG8_MMA(1, 1, At, B1); PG8_BAR; PG8_SCHED;
        }
        if (wr == 0) PG8_BAR;
        E(acc, cur, wr, wc, fr, fq);
        if (!has_next) break;
#pragma unroll
        for (int a = 0; a < 2; ++a)
#pragma unroll
            for (int b = 0; b < 2; ++b)
#pragma unroll
                for (int m = 0; m < 4; ++m)
#pragma unroll
                    for (int n = 0; n < 2; ++n) acc[a][b][m][n] = (f32x4){0.f, 0.f, 0.f, 0.f};
        cur = nxt; cA = nA; cB = nB; ++ui;
        if (wr == 1) PG8_BAR;
    }
    PG8_WAIT_V(0);
    PG8_BAR;
#undef PG8_SA
#undef PG8_SB
#undef PG8_STAGE
#undef PG8_LDA
#undef PG8_LDB
#undef PG8_MMA
#undef PG8_WAIT_V
#undef PG8_WAIT_L
#undef PG8_BAR
#undef PG8_SCHED
}
}

namespace att {
typedef LAS const char* lds_cptr;
typedef short v4i16_t __attribute__((ext_vector_type(4)));
__device__ __forceinline__ int crow(int r, int hi) { return (r & 3) + 8 * (r >> 2) + 4 * hi; }
__device__ __forceinline__ void glds16(const void* gsrc, unsigned lds_dst) { unsigned keep;
    asm volatile("s_mov_b32 %0, m0\n\ts_mov_b32 m0, %2\n\ts_nop 0\n\tglobal_load_lds_dwordx4 %1, off\n\ts_mov_b32 m0, %0" : "=&s"(keep) : "v"(gsrc), "s"(lds_dst) : "memory"); }
__device__ __forceinline__ unsigned cvtpk(float lo, float hi) { return pg8::cvt_pk_bf16(lo, hi); }
__device__ __forceinline__ s16x4 vtr(lds_cptr p) { return __builtin_bit_cast(s16x4, __builtin_amdgcn_ds_read_tr16_b64_v4i16((LAS v4i16_t*)p)); }
__device__ __forceinline__ float halfmax(float m) { auto rr = __builtin_amdgcn_permlane32_swap(__float_as_uint(m), __float_as_uint(m), false, false); return fmaxf(__uint_as_float(rr[0]), __uint_as_float(rr[1])); }
__device__ __forceinline__ float halfsum(float m) { auto rr = __builtin_amdgcn_permlane32_swap(__float_as_uint(m), __float_as_uint(m), false, false); return __uint_as_float(rr[0]) + __uint_as_float(rr[1]); }
#define WAIT_BAR(N) asm volatile("s_waitcnt vmcnt(" #N ") lgkmcnt(0)\n\ts_barrier" ::: "memory")
#define VFRAG(lo, hi) (bf16x8){lo[0], lo[1], lo[2], lo[3], hi[0], hi[1], hi[2], hi[3]}

constexpr int NSLOT = 3, KSLOT = 12288, VSLOT = 8192;
constexpr int LDS_K = 0, LDS_V = NSLOT * KSLOT, LDS_OST = LDS_V + NSLOT * VSLOT, OST_W = 32 * 144, LDS_END = LDS_OST + 8 * OST_W;
static_assert(LDS_END <= 131072, "attention LDS");
constexpr float THRL = 8.f;

__device__ __forceinline__ void mla_unit(int b, int h, int qb, const bf16_t* MQ, const bf16_t* MKV, const bf16_t* KPE, bf16_t* MIX, LAS unsigned char* shm) {
    const int tid = threadIdx.x, lane = tid & 63, r32 = lane & 31, hi = lane >> 5; const int wid = __builtin_amdgcn_readfirstlane(tid >> 6);
    const long rowbase = (long)b * SEQ; const int q0 = qb * 256;
    const bf16_t* Qw = MQ + (rowbase + q0 + wid * 32) * LD_MQ + h * 96;
    const unsigned lds0 = (unsigned)(uintptr_t)shm;
    const bf16_t* ksrc0 = MKV + (rowbase + lane) * LD_MKV + h * 128 + wid * 8;
    const bf16_t* ksrc1 = KPE + (rowbase + lane) * LD_KPE + (wid & 3) * 8;
    const bf16_t* vsrc = MKV + (rowbase + 16 * (wid & 3) + (lane >> 2)) * LD_MKV + h * 128 + 64 + (wid >> 2) * 32 + (lane & 3) * 8;
    const unsigned kdst0 = lds0 + LDS_K + wid * 1024, kdst1 = lds0 + LDS_K + (8 + (wid & 3)) * 1024, vdst = lds0 + LDS_V + wid * 1024;
#define DMA_T(t, s) do { glds16(ksrc0 + (long)(t) * 64 * LD_MKV, (unsigned)__builtin_amdgcn_readfirstlane(kdst0 + (s) * KSLOT)); \
                         glds16(ksrc1 + (long)(t) * 64 * LD_KPE, (unsigned)__builtin_amdgcn_readfirstlane(kdst1 + (s) * KSLOT)); \
                         glds16(vsrc + (long)(t) * 64 * LD_MKV, (unsigned)__builtin_amdgcn_readfirstlane(vdst + (s) * VSLOT)); } while (0)
    const lds_cptr shm3 = (lds_cptr)shm;
    const lds_cptr kp0 = shm3 + LDS_K + hi * 1024 + r32 * 16;
    const lds_cptr vp0 = shm3 + LDS_V + ((lane >> 4) & 1) * 32 + (lane & 3) * 8 + (4 * hi + ((lane & 15) >> 2)) * 64;
    constexpr int NT = SEQ / 64;
    DMA_T(0, 0); DMA_T(1, 1);
    bf16x8 qr[6];
#pragma unroll
    for (int d0 = 0; d0 < 6; ++d0) qr[d0] = *(const bf16x8*)(Qw + (long)r32 * LD_MQ + d0 * 16 + hi * 8);
    float mhat = 0.f, l_reg = 0.f; f32x16 o[2]; o[0] = f32x16{}; o[1] = f32x16{}; f32x16 negm = f32x16{};
    int sl = 0;
#pragma unroll 1
    for (int t = 0; t < NT; ++t) {
        if (t + 1 < NT) WAIT_BAR(3); else WAIT_BAR(0);
        { int s2 = sl + 2; if (s2 >= 3) s2 -= 3; if (t + 2 < NT) DMA_T(t + 2, s2); }
        f32x16 C0 = negm, C1 = negm;
        const lds_cptr kp = kp0 + sl * KSLOT;
#pragma unroll
        for (int d0 = 0; d0 < 6; ++d0) {
            const bf16x8 k0 = *(const LAS bf16x8*)(kp + d0 * 2048), k1 = *(const LAS bf16x8*)(kp + d0 * 2048 + 512);
            C0 = __builtin_amdgcn_mfma_f32_32x32x16_bf16(k0, qr[d0], C0, 0, 0, 0);
            C1 = __builtin_amdgcn_mfma_f32_32x32x16_bf16(k1, qr[d0], C1, 0, 0, 0);
        }
        float rm = fmaxf(C0[0], C1[0]);
#pragma unroll
        for (int r = 1; r < 16; ++r) rm = fmaxf(rm, fmaxf(C0[r], C1[r]));
        rm = halfmax(rm);
        if (t == 0 || __any(rm > THRL)) {
            const float dl = (t == 0) ? rm : fmaxf(rm, 0.f);
            mhat += dl;
#pragma unroll
            for (int r = 0; r < 16; ++r) { C0[r] -= dl; C1[r] -= dl; negm[r] = -mhat; }
            if (t > 0) { const float f = __builtin_amdgcn_exp2f(-dl); l_reg *= f;
#pragma unroll
                for (int r = 0; r < 16; ++r) { o[0][r] *= f; o[1][r] *= f; } }
        }
        float sacc = 0.f;
#pragma unroll
        for (int r = 0; r < 16; ++r) { C0[r] = __builtin_amdgcn_exp2f(C0[r]); C1[r] = __builtin_amdgcn_exp2f(C1[r]); sacc += C0[r] + C1[r]; }
        l_reg += sacc;
        u32x4 pw[4];
#pragma unroll
        for (int k = 0; k < 4; ++k) { pw[0][k] = cvtpk(C0[2 * k], C0[2 * k + 1]); pw[1][k] = cvtpk(C0[8 + 2 * k], C0[9 + 2 * k]); pw[2][k] = cvtpk(C1[2 * k], C1[2 * k + 1]); pw[3][k] = cvtpk(C1[8 + 2 * k], C1[9 + 2 * k]); }
        const lds_cptr vp = vp0 + sl * VSLOT;
#pragma unroll
        for (int d0 = 0; d0 < 2; ++d0)
#pragma unroll
            for (int ks = 0; ks < 4; ++ks) {
                const s16x4 lo = vtr(vp + d0 * 4096 + ks * 1024), hh = vtr(vp + d0 * 4096 + ks * 1024 + 512);
                o[d0] = __builtin_amdgcn_mfma_f32_32x32x16_bf16(VFRAG(lo, hh), __builtin_bit_cast(bf16x8, pw[ks]), o[d0], 0, 0, 0);
            }
        sl = (sl == 2) ? 0 : sl + 1;
    }
    l_reg = halfsum(l_reg);
    const float inv = 1.0f / l_reg;
    LAS unsigned char* stg = shm + LDS_OST + wid * OST_W;
#pragma unroll
    for (int d0 = 0; d0 < 2; ++d0)
#pragma unroll
        for (int rq = 0; rq < 4; ++rq) {
            u32x2 w; w.x = cvtpk(o[d0][4 * rq] * inv, o[d0][4 * rq + 1] * inv); w.y = cvtpk(o[d0][4 * rq + 2] * inv, o[d0][4 * rq + 3] * inv);
            *(LAS u32x2*)(stg + r32 * 144 + (32 * d0 + 8 * rq + 4 * hi) * 2) = w;
        }
    asm volatile("s_waitcnt lgkmcnt(0)" ::: "memory");
    bf16_t* Ow = MIX + (rowbase + q0 + wid * 32) * LD_MIX + 256 + h * 64;
#pragma unroll
    for (int i = 0; i < 4; ++i) { const int id = i * 64 + lane, row = id >> 3, ch = id & 7; const u32x4 v = *(const LAS u32x4*)(stg + row * 144 + ch * 16); *(u32x4*)(Ow + (long)row * LD_MIX + ch * 8) = v; }
    asm volatile("s_waitcnt lgkmcnt(0)\n\ts_barrier" ::: "memory");
#undef DMA_T
}

__device__ __forceinline__ void dil_task(int b, int hg, int c5, int r, const bf16_t* QKVA, bf16_t* MIX, LAS unsigned char* vl) {
    const int lane = threadIdx.x & 63, r32 = lane & 31, hi = lane >> 5;
    const long rowb = (long)b * SEQ;
    const int tq = 512 * c5 + r + 16 * r32;
    float m = -1e30f, l = 0.f; f32x16 o[2]; o[0] = f32x16{}; o[1] = f32x16{};
    const lds_cptr vp = (lds_cptr)vl + ((lane >> 4) & 1) * 32 + (lane & 3) * 8 + (4 * hi + ((lane & 15) >> 2)) * 64;
#pragma unroll 1
    for (int g = 0; g < 3; ++g) {
        const int sh = 2 * g, d = 1 << sh, sq = 16 >> sh, L = SEQ >> sh, nblk = (g == 0) ? 20 : (g == 1 ? 8 : 5), head = 4 * g + hg;
        const int rho = r & (d - 1), lq0 = (512 * c5 + r - rho) >> sh, lk0 = lq0 - 64, lq = lq0 + sq * r32;
        const bf16_t* Kb = QKVA + 768 + head * 64 + hi * 8;
        const bf16_t* Vb = QKVA + 1536 + head * 64;
        bf16x8 qf[4];
#pragma unroll
        for (int d0 = 0; d0 < 4; ++d0) qf[d0] = *(const bf16x8*)(QKVA + (rowb + tq) * LD_QKVA + head * 64 + d0 * 16 + hi * 8);
        bf16x8 kf[4]; u32x4 vv[4];
#define DIL_LOAD(kb) do { int lk = lk0 + 32 * (kb) + r32; lk = lk < 0 ? 0 : (lk > L - 1 ? L - 1 : lk); const bf16_t* kr = Kb + (rowb + (long)lk * d + rho) * LD_QKVA; \
            _Pragma("unroll") for (int d0 = 0; d0 < 4; ++d0) kf[d0] = *(const bf16x8*)(kr + d0 * 16); \
            _Pragma("unroll") for (int ii = 0; ii < 4; ++ii) { const int id = ii * 64 + lane, key = id >> 3, c8 = id & 7; int lv = lk0 + 32 * (kb) + key; lv = lv < 0 ? 0 : (lv > L - 1 ? L - 1 : lv); \
                vv[ii] = *(const u32x4*)(Vb + (rowb + (long)lv * d + rho) * LD_QKVA + c8 * 8); } } while (0)
        DIL_LOAD(0);
#pragma unroll 1
        for (int kb = 0; kb < nblk; ++kb) {
#pragma unroll
            for (int ii = 0; ii < 4; ++ii) { const int id = ii * 64 + lane, key = id >> 3, c8 = id & 7; *(LAS u32x4*)(vl + ((c8 >> 2) * 2 + (key >> 4)) * 1024 + (key & 15) * 64 + (c8 & 3) * 16) = vv[ii]; }
            f32x16 C = f32x16{};
#pragma unroll
            for (int d0 = 0; d0 < 4; ++d0) C = __builtin_amdgcn_mfma_f32_32x32x16_bf16(kf[d0], qf[d0], C, 0, 0, 0);
            if (kb + 1 < nblk) DIL_LOAD(kb + 1);
            const int kbase = lk0 + 32 * kb;
            float rm = -INFINITY;
#pragma unroll
            for (int rr = 0; rr < 16; ++rr) { const int lk = kbase + crow(rr, hi); const int df = lq - lk; const bool ok = (lk >= 0) && (lk < L) && (df <= 64) && (df >= -64); C[rr] = ok ? C[rr] : -INFINITY; rm = fmaxf(rm, C[rr]); }
            rm = halfmax(rm);
            const float mn = fmaxf(m, rm), f = __builtin_amdgcn_exp2f(m - mn); m = mn; l *= f;
#pragma unroll
            for (int rr = 0; rr < 16; ++rr) { o[0][rr] *= f; o[1][rr] *= f; }
            float sacc = 0.f;
#pragma unroll
            for (int rr = 0; rr < 16; ++rr) { C[rr] = __builtin_amdgcn_exp2f(C[rr] - mn); sacc += C[rr]; }
            l += sacc;
            u32x4 pw[2];
#pragma unroll
            for (int k = 0; k < 4; ++k) { pw[0][k] = cvtpk(C[2 * k], C[2 * k + 1]); pw[1][k] = cvtpk(C[8 + 2 * k], C[9 + 2 * k]); }
#pragma unroll
            for (int d0 = 0; d0 < 2; ++d0)
#pragma unroll
                for (int ks = 0; ks < 2; ++ks) {
                    const s16x4 lo = vtr(vp + d0 * 2048 + ks * 1024), hh = vtr(vp + d0 * 2048 + ks * 1024 + 512);
                    o[d0] = __builtin_amdgcn_mfma_f32_32x32x16_bf16(VFRAG(lo, hh), __builtin_bit_cast(bf16x8, pw[ks]), o[d0], 0, 0, 0);
                }
        }
#undef DIL_LOAD
    }
    l = halfsum(l);
    const float inv = 1.0f / l;
    bf16_t* Ow = MIX + (rowb + tq) * LD_MIX + hg * 64;
#pragma unroll
    for (int d0 = 0; d0 < 2; ++d0)
#pragma unroll
        for (int rq = 0; rq < 4; ++rq) {
            u32x2 w; w.x = cvtpk(o[d0][4 * rq] * inv, o[d0][4 * rq + 1] * inv); w.y = cvtpk(o[d0][4 * rq + 2] * inv, o[d0][4 * rq + 3] * inv);
            *(u32x2*)(Ow + 32 * d0 + 8 * rq + 4 * hi) = w;
        }
}
#undef WAIT_BAR
#undef VFRAG
}

constexpr int NWAVES = 8;
constexpr int RING_OFF = 0, RING_BYTES = 131072;
constexpr int LDSCTL_OFF = RING_BYTES, MISC_OFF = LDSCTL_OFF + 320;
constexpr int LDS_BYTES = 147456;
constexpr int CW_BAR = 4096;
constexpr int N_PHASES = 10;
constexpr int N_LAUNCHES = MK_N_LAUNCHES;

#define XB_TMO      128
#define XB_XCNT(j)  (256  + 64 * (j))
#define XB_XSUB(j)  (1280 + 64 * (j))
#define XB_XGEN(j)  (2304 + 64 * (j))
#define XB_TOP      3328
#define XB_TOPGEN   3392
#define XCD_BAR_WORDS 3456
#define XB_SPIN_CAP (1u << 18)
static_assert((CW_BAR + XCD_BAR_WORDS) * 4 <= (int)CTL_ZERO_BYTES, "ctl");
__device__ __forceinline__ unsigned xb_ld(unsigned* p)              { return __hip_atomic_load(p, __ATOMIC_RELAXED, __HIP_MEMORY_SCOPE_AGENT); }
__device__ __forceinline__ unsigned xb_add(unsigned* p, unsigned v) { return __hip_atomic_fetch_add(p, v, __ATOMIC_RELAXED, __HIP_MEMORY_SCOPE_AGENT); }
__device__ __forceinline__ unsigned xb_xcc_id() { return (unsigned)__builtin_amdgcn_s_getreg((3 << 11) | 20) & 0xFu; }
#define XB_SPIN(cond, bar) do { unsigned _sp = 0; while (cond) { __builtin_amdgcn_s_sleep(1); \
    if ((++_sp & 255u) == 0u) { if (xb_ld(&(bar)[XB_TMO])) break; if (_sp > XB_SPIN_CAP) { atomicAdd(&(bar)[XB_TMO], 1u); break; } } } } while (0)
struct XcdBarrier { unsigned* bar; unsigned x; volatile LAS unsigned* st; };
__device__ __forceinline__ XcdBarrier xcd_barrier_post(unsigned* bar, volatile LAS unsigned* st) {
    XcdBarrier b; b.bar = bar; b.x = xb_xcc_id(); b.st = st;
    if (threadIdx.x == 0) (void)xb_add(&bar[XB_XCNT(b.x)], 1u);
    return b;
}
__device__ __forceinline__ void xcd_barrier_complete(unsigned* bar, unsigned x, unsigned& nloc, unsigned& nx) {
    const unsigned G = gridDim.x * gridDim.y * gridDim.z;
    unsigned sum, cnt, mine, sp = 0u;
    for (;;) {
        sum = 0u; cnt = 0u; mine = 0u;
#pragma unroll
        for (unsigned j = 0; j < 16; ++j) { const unsigned c = xb_ld(&bar[XB_XCNT(j)]); sum += c; cnt += (c > 0u) ? 1u : 0u; mine = (j == x) ? c : mine; }
        if (sum == G) break;
        __builtin_amdgcn_s_sleep(1);
        if ((++sp & 255u) == 0u) { if (xb_ld(&bar[XB_TMO])) break; if (sp > XB_SPIN_CAP) { atomicAdd(&bar[XB_TMO], 1u); break; } }
    }
    nloc = mine > 0u ? mine : 1u; nx = cnt > 0u ? cnt : 1u;
}
__device__ __forceinline__ void xcd_barrier(const XcdBarrier& b) {
    asm volatile("s_waitcnt vmcnt(0)" ::: "memory");
    __syncthreads();
    if (threadIdx.x == 0) {
        unsigned* bar = b.bar;
        __builtin_amdgcn_s_waitcnt(0);
        unsigned nloc = b.st[0], nx = b.st[1];
        if (nloc == 0u) { xcd_barrier_complete(bar, b.x, nloc, nx); b.st[0] = nloc; b.st[1] = nx; }
        const unsigned old = xb_add(&bar[XB_XSUB(b.x)], 1u);
        const unsigned gen = old / nloc;
        if (old + 1u == (gen + 1u) * nloc) {
            __builtin_amdgcn_fence(__ATOMIC_RELEASE, "agent");
            asm volatile("s_waitcnt vmcnt(0)" ::: "memory");
            const unsigned og = xb_add(&bar[XB_TOP], 1u);
            const unsigned tg = og / nx;
            if (og + 1u == (tg + 1u) * nx) xb_add(&bar[XB_TOPGEN], 1u);
            else XB_SPIN(xb_ld(&bar[XB_TOPGEN]) == tg, bar);
            __builtin_amdgcn_fence(__ATOMIC_ACQUIRE, "agent");
            xb_add(&bar[XB_XGEN(b.x)], 1u);
            asm volatile("s_waitcnt vmcnt(0)" ::: "memory");
        } else {
            XB_SPIN(xb_ld(&bar[XB_XGEN(b.x)]) == gen, bar);
            __builtin_amdgcn_fence(__ATOMIC_ACQUIRE, "agent");
            asm volatile("s_waitcnt vmcnt(0)" ::: "memory");
        }
    }
    __syncthreads();
}

__device__ __forceinline__ unsigned f2bf(float f) { unsigned u = __builtin_bit_cast(unsigned, f); return (u + 0x7fffu + ((u >> 16) & 1u)) >> 16; }
__device__ __forceinline__ unsigned pk2(float lo, float hi) { return f2bf(lo) | (f2bf(hi) << 16); }
__device__ __forceinline__ float wave_sum(float v) {
#pragma unroll
    for (int o = 1; o < 64; o <<= 1) v += __shfl_xor(v, o);
    return v;
}
__device__ __forceinline__ void transpose_item(const float* W, int N, bf16_t* WT, int ldk, int koff, int drow0, const float* kgain, LAS float* scr, int k0, int n0, int lane) {
#pragma unroll 8
    for (int i = 0; i < 32; ++i) { const int kk = 2 * i + (lane >> 5); float w = W[(size_t)(k0 + kk) * N + n0 + (lane & 31)]; if (kgain) w *= kgain[k0 + kk]; scr[kk * 33 + (lane & 31)] = w; }
    asm volatile("s_waitcnt lgkmcnt(0)" ::: "memory");
    const int c = lane & 7;
#pragma unroll
    for (int j = 0; j < 4; ++j) { const int n = (lane >> 3) + 8 * j; const LAS float* s = scr + (8 * c) * 33 + n;
        u32x4 o; o.x = pk2(s[0 * 33], s[1 * 33]); o.y = pk2(s[2 * 33], s[3 * 33]); o.z = pk2(s[4 * 33], s[5 * 33]); o.w = pk2(s[6 * 33], s[7 * 33]);
        *(u32x4*)(WT + (size_t)(drow0 + n) * ldk + koff + k0 + 8 * c) = o; }
    asm volatile("s_waitcnt lgkmcnt(0)" ::: "memory");
}

struct Args {
    const float* in[16]; float* out; unsigned char* ws;
    float invA[8]; float invB[16];
    int ph_lo, ph_hi;
};

__global__ void __launch_bounds__(NWAVES * 64, 2) mega_fwd(Args args) {
    extern __shared__ __attribute__((aligned(16))) unsigned char lds_raw[];
    LAS unsigned char* lds = (LAS unsigned char*)lds_raw;
    volatile LAS unsigned* MISC = (volatile LAS unsigned*)(lds + MISC_OFF);
    const int tid = threadIdx.x, lane = tid & 63, wave = __builtin_amdgcn_readfirstlane(tid >> 6);
    const int G = gridDim.x; const int bx = blockIdx.x;
    const int vcu = (G % 8 == 0) ? (bx % 8) * (G / 8) + bx / 8 : bx;
    unsigned char* ws = args.ws;
    const float* x = args.in[0];
    float* out = args.out;
    bf16_t* Win_t = (bf16_t*)(ws + WS_WIN); bf16_t* Wuq_t = (bf16_t*)(ws + WS_WUQ); bf16_t* Wukv_t = (bf16_t*)(ws + WS_WUKV); bf16_t* Wo_t = (bf16_t*)(ws + WS_WO);
    bf16_t* Wout_t = (bf16_t*)(ws + WS_WOUT); bf16_t* Wf1_t = (bf16_t*)(ws + WS_WF1); bf16_t* Wf2_t = (bf16_t*)(ws + WS_WF2);
    float* CSA = (float*)(ws + WS_CSA); float* CSB = (float*)(ws + WS_CSB); float* SSQ = (float*)(ws + WS_SSQ);
    bf16_t* XN = (bf16_t*)(ws + WS_XN); bf16_t* MKV = XN; bf16_t* HN = (bf16_t*)(ws + WS_HN);
    bf16_t* QKVA = (bf16_t*)(ws + WS_QKVA); bf16_t* QC = (bf16_t*)(ws + WS_QC); bf16_t* KVC = (bf16_t*)(ws + WS_KVC); bf16_t* KPE = (bf16_t*)(ws + WS_KPE);
    bf16_t* MQ = (bf16_t*)(ws + WS_MQ); bf16_t* MIX = (bf16_t*)(ws + WS_MIX); bf16_t* U = (bf16_t*)(ws + WS_U); bf16_t* HID = (bf16_t*)(ws + WS_HID);
    float* MIXF = (float*)(ws + WS_F32); float* FFO = (float*)(ws + WS_FFO);
    bf16_t* GATES = (bf16_t*)out;

    for (int u = tid; u < (LDS_BYTES - LDSCTL_OFF) / 4; u += NWAVES * 64) ((LAS unsigned*)(lds + LDSCTL_OFF))[u] = 0u;
    __syncthreads();
    XcdBarrier bar; bar.bar = (unsigned*)(ws + WS_CTL) + CW_BAR; bar.x = 0; bar.st = nullptr;
    if (N_LAUNCHES == 1) bar = xcd_barrier_post((unsigned*)(ws + WS_CTL) + CW_BAR, MISC + 8);
    const int lo = args.ph_lo, hi_ph = args.ph_hi;
#ifndef PH_MASK
#define PH_MASK 0x3ff
#endif
#define IN(k) (((PH_MASK >> (k)) & 1) && lo <= (k) && (k) < hi_ph)
#define SEAM(k) do { if (IN(k) && IN((k) + 1)) xcd_barrier(bar); } while (0)
    const int gw = vcu * NWAVES + wave, NGW = G * NWAVES;

    if (IN(0)) {
        LAS float* scr = (LAS float*)(lds + RING_OFF + wave * 16384);
        constexpr int I_IN = (1024 / 64) * (IN_TOTAL / 32), I_UQ = (512 / 64) * (768 / 32), I_UKV = (256 / 64) * (1024 / 32), I_OA = (256 / 64) * (1024 / 32), I_OB = (512 / 64) * (1024 / 32),
                      I_OUT = (1024 / 64) * (1024 / 32), I_F1 = (1024 / 64) * (4096 / 32), I_F2 = (4096 / 64) * (1024 / 32);
        constexpr int NITEMS = I_IN + I_UQ + I_UKV + I_OA + I_OB + I_OUT + I_F1 + I_F2;
        for (int it = gw; it < NITEMS; it += NGW) {
            int r = it;
            if (r < I_IN) { const int nblk = IN_TOTAL / 32, kb = r / nblk, nb = r % nblk, n0 = 32 * nb;
                int dshift = 0; if (n0 >= 3072 && n0 < 3104) dshift = 5120 - 3072; else if (n0 >= 3104) dshift = -32;
                transpose_item(args.in[2], IN_TOTAL, Win_t, 1024, 0, n0 + dshift, nullptr, scr, 64 * kb, n0, lane); continue; } r -= I_IN;
            if (r < I_UQ) { const int nblk = 768 / 32; transpose_item(args.in[5], 768, Wuq_t, 512, 0, 32 * (r % nblk), args.in[4], scr, 64 * (r / nblk), 32 * (r % nblk), lane); continue; } r -= I_UQ;
            if (r < I_UKV) { const int nblk = 1024 / 32; transpose_item(args.in[7], 1024, Wukv_t, 256, 0, 32 * (r % nblk), args.in[6], scr, 64 * (r / nblk), 32 * (r % nblk), lane); continue; } r -= I_UKV;
            if (r < I_OA) { const int nblk = 1024 / 32; transpose_item(args.in[8], 1024, Wo_t, 768, 0, 32 * (r % nblk), nullptr, scr, 64 * (r / nblk), 32 * (r % nblk), lane); continue; } r -= I_OA;
            if (r < I_OB) { const int nblk = 1024 / 32; transpose_item(args.in[9], 1024, Wo_t, 768, 256, 32 * (r % nblk), nullptr, scr, 64 * (r / nblk), 32 * (r % nblk), lane); continue; } r -= I_OB;
            if (r < I_OUT) { const int nblk = 1024 / 32; transpose_item(args.in[10], 1024, Wout_t, 1024, 0, 32 * (r % nblk), nullptr, scr, 64 * (r / nblk), 32 * (r % nblk), lane); continue; } r -= I_OUT;
            if (r < I_F1) { const int nblk = 4096 / 32; transpose_item(args.in[13], 4096, Wf1_t, 1024, 0, 32 * (r % nblk), nullptr, scr, 64 * (r / nblk), 32 * (r % nblk), lane); continue; } r -= I_F1;
            { const int nblk = 1024 / 32; transpose_item(args.in[14], 1024, Wf2_t, 4096, 0, 32 * (r % nblk), nullptr, scr, 64 * (r / nblk), 32 * (r % nblk), lane); }
        }
        for (int i = gw * 64 + lane; i < (NPROJ - IN_TOTAL) * 1024 / 8; i += NGW * 64) ((u32x4*)(Win_t + (size_t)IN_TOTAL * 1024))[i] = (u32x4){0u, 0u, 0u, 0u};
        for (int i = gw * 64 + lane; i < SEQ * 24; i += NGW * 64) {
            const int pos = i / 24, j = i % 24; const float inv = (j < 8) ? args.invA[j] : args.invB[j - 8];
            const float ang = (float)pos * inv; double rev = (double)ang * 0.15915494309189535; rev -= __builtin_floor(rev); const float fr = (float)rev;
            const float c = __builtin_amdgcn_cosf(fr), s = __builtin_amdgcn_sinf(fr);
            if (j < 8) { CSA[pos * 16 + j] = c; CSA[pos * 16 + 8 + j] = s; } else { CSB[pos * 32 + (j - 8)] = c; CSB[pos * 32 + 16 + (j - 8)] = s; }
        }
        const float* gpre = args.in[1];
        for (int m = gw; m < M; m += NGW) {
            const f32x4* xr = (const f32x4*)(x + (size_t)m * DM) + lane; f32x4 v[4]; float s = 0.f;
#pragma unroll
            for (int j = 0; j < 4; ++j) { v[j] = xr[64 * j]; s += (v[j].x * v[j].x + v[j].y * v[j].y) + (v[j].z * v[j].z + v[j].w * v[j].w); }
            const float rstd = __builtin_amdgcn_rsqf(wave_sum(s) * (1.f / DM) + EPS);
            unsigned long long* o8 = (unsigned long long*)(XN + (size_t)m * DM) + lane;
#pragma unroll
            for (int j = 0; j < 4; ++j) { const f32x4 gg = ((const f32x4*)gpre)[lane + 64 * j];
                o8[64 * j] = (unsigned long long)pk2(v[j].x * rstd * gg.x, v[j].y * rstd * gg.y) | ((unsigned long long)pk2(v[j].z * rstd * gg.z, v[j].w * rstd * gg.w) << 32); }
        }
    }
    SEAM(0);
    if (IN(1)) {
        pg8::Gemm g{XN, Win_t, 1024, 1024, 1024}; pg8::StaticOrder S; S.init(M, NPROJ, G, bx);
        pg8::Epi<0> E; E.a = pg8::EpiArgs{QKVA, QC, KVC, GATES, KPE, nullptr, SSQ, args.in[3], CSA, CSB, nullptr};
        pg8::gemm_phase(lds + RING_OFF, g, S, E);
    }
    SEAM(1);
    if (IN(2)) {
        { pg8::Gemm g{QC, Wuq_t, LD_QC, 512, 512}; pg8::StaticOrder S; S.init(M, 768, G, bx);
          pg8::Epi<1> E; E.a = pg8::EpiArgs{MQ, nullptr, nullptr, nullptr, nullptr, nullptr, SSQ, nullptr, CSA, CSB, nullptr};
          pg8::gemm_phase(lds + RING_OFF, g, S, E); }
        { pg8::Gemm g{KVC, Wukv_t, LD_KVC, 256, 256}; pg8::StaticOrder S; S.init(M, 1024, G, bx);
          pg8::Epi<2> E; E.a = pg8::EpiArgs{MKV, nullptr, nullptr, nullptr, nullptr, nullptr, SSQ, nullptr, CSA, CSB, nullptr};
          pg8::gemm_phase(lds + RING_OFF, g, S, E); }
    }
    SEAM(2);
    if (IN(3)) {
        {
            for (int task = gw; task < 2048; task += NGW) {
                const int cu = task >> 3, w = task & 7;
                att::dil_task(cu >> 7, (cu >> 1) & 3, (cu >> 3) & 15, ((cu & 1) << 3) | w, QKVA, MIX, lds + RING_OFF + wave * 4096);
            }
        }
        asm volatile("s_waitcnt vmcnt(0) lgkmcnt(0)" ::: "memory");
        __syncthreads();
        for (int uix = vcu; uix < 512; uix += G) {
            att::mla_unit((uix >> 5) >> 3, (uix >> 5) & 7, uix & 31, MQ, MKV, KPE, MIX, lds + RING_OFF);
        }
    }
    SEAM(3);
    if (IN(4)) {
        { pg8::Gemm g{MIX, Wo_t, LD_MIX, 768, 256}; pg8::StaticOrder S; S.init(M, 1024, G, bx);
          pg8::Epi<3> E; E.a = pg8::EpiArgs{U, nullptr, nullptr, nullptr, nullptr, nullptr, nullptr, nullptr, nullptr, nullptr, GATES};
          pg8::gemm_phase(lds + RING_OFF, g, S, E); }
        asm volatile("s_waitcnt vmcnt(0)" ::: "memory"); __syncthreads();
        { pg8::Gemm g{MIX + 256, Wo_t + 256, LD_MIX, 768, 512}; pg8::StaticOrder S; S.init(M, 1024, G, bx);
          pg8::Epi<4> E; E.a = pg8::EpiArgs{U, nullptr, nullptr, nullptr, nullptr, nullptr, nullptr, nullptr, nullptr, nullptr, GATES};
          pg8::gemm_phase(lds + RING_OFF, g, S, E); }
    }
    SEAM(4);
    if (IN(5)) {
        pg8::Gemm g{U, Wout_t, 1024, 1024, 1024}; pg8::StaticOrder S; S.init(M, 1024, G, bx);
        pg8::Epi<5> E; E.a = pg8::EpiArgs{nullptr, nullptr, nullptr, nullptr, nullptr, MIXF, SSQ, nullptr, nullptr, nullptr, nullptr};
        pg8::gemm_phase(lds + RING_OFF, g, S, E);
    }
    SEAM(5);
    if (IN(6)) {
        const float* gpost = args.in[11]; const float* gmlp = args.in[12];
        for (int m = gw; m < M; m += NGW) {
            float ss = 0.f; { const f32x4* sp = (const f32x4*)(SSQ + (size_t)m * 16);
#pragma unroll
                for (int j = 0; j < 4; ++j) { const f32x4 t = sp[j]; ss += (t.x + t.y) + (t.z + t.w); } }
            const float r1 = __builtin_amdgcn_rsqf(ss * (1.f / DM) + EPS);
            const f32x4* xr = (const f32x4*)(x + (size_t)m * DM) + lane; const f32x4* mr = (const f32x4*)(MIXF + (size_t)m * DM) + lane; f32x4* hr = (f32x4*)(out + (size_t)m * DM) + lane;
            f32x4 hv[4]; float s = 0.f;
#pragma unroll
            for (int j = 0; j < 4; ++j) { const f32x4 gg = ((const f32x4*)gpost)[lane + 64 * j]; hv[j] = xr[64 * j] + mr[64 * j] * r1 * gg; hr[64 * j] = hv[j]; s += (hv[j].x * hv[j].x + hv[j].y * hv[j].y) + (hv[j].z * hv[j].z + hv[j].w * hv[j].w); }
            const float r2 = __builtin_amdgcn_rsqf(wave_sum(s) * (1.f / DM) + EPS);
            unsigned long long* o8 = (unsigned long long*)(HN + (size_t)m * DM) + lane;
#pragma unroll
            for (int j = 0; j < 4; ++j) { const f32x4 gg = ((const f32x4*)gmlp)[lane + 64 * j];
                o8[64 * j] = (unsigned long long)pk2(hv[j].x * r2 * gg.x, hv[j].y * r2 * gg.y) | ((unsigned long long)pk2(hv[j].z * r2 * gg.z, hv[j].w * r2 * gg.w) << 32); }
        }
    }
    SEAM(6);
    if (IN(7)) {
        pg8::Gemm g{HN, Wf1_t, 1024, 1024, 1024}; pg8::StaticOrder S; S.init(M, FF, G, bx);
        pg8::Epi<6> E; E.a = pg8::EpiArgs{HID, nullptr, nullptr, nullptr, nullptr, nullptr, nullptr, nullptr, nullptr, nullptr, nullptr};
        pg8::gemm_phase(lds + RING_OFF, g, S, E);
    }
    SEAM(7);
    if (IN(8)) {
        pg8::Gemm g{HID, Wf2_t, FF, FF, FF}; pg8::StaticOrder S; S.init(M, 1024, G, bx);
        pg8::Epi<5> E; E.a = pg8::EpiArgs{nullptr, nullptr, nullptr, nullptr, nullptr, FFO, SSQ, nullptr, nullptr, nullptr, nullptr};
        pg8::gemm_phase(lds + RING_OFF, g, S, E);
    }
    SEAM(8);
    if (IN(9)) {
        const float* gp = args.in[15];
        for (int m = gw; m < M; m += NGW) {
            float ss = 0.f; { const f32x4* sp = (const f32x4*)(SSQ + (size_t)m * 16);
#pragma unroll
                for (int j = 0; j < 4; ++j) { const f32x4 t = sp[j]; ss += (t.x + t.y) + (t.z + t.w); } }
            const float r1 = __builtin_amdgcn_rsqf(ss * (1.f / DM) + EPS);
            const f32x4* fr = (const f32x4*)(FFO + (size_t)m * DM) + lane; f32x4* hr = (f32x4*)(out + (size_t)m * DM) + lane;
#pragma unroll
            for (int j = 0; j < 4; ++j) { const f32x4 gg = ((const f32x4*)gp)[lane + 64 * j]; hr[64 * j] = hr[64 * j] + fr[64 * j] * r1 * gg; }
        }
    }
#undef IN
#undef SEAM
}

extern "C" void kernel_launch(void* const* d_in, const int* in_sizes, int n_in, void* d_out, int out_size, void* d_ws, size_t ws_size, hipStream_t stream) {
    static int grid = 0;
    if (grid == 0) {
        if (n_in != 16 || in_sizes[0] != M * DM || out_size != M * DM || ws_size < 256 * MiB) { fprintf(stderr, "kernel_launch: unexpected shapes (n_in %d, ws %zu)\n", n_in, ws_size); grid = -1; return; }
        int dev = 0, cus = 0, per_cu = 0;
        if (hipGetDevice(&dev) != hipSuccess || hipDeviceGetAttribute(&cus, hipDeviceAttributeMultiprocessorCount, dev) != hipSuccess) { grid = -1; return; }
        if (hipFuncSetAttribute((const void*)mega_fwd, hipFuncAttributeMaxDynamicSharedMemorySize, LDS_BYTES) != hipSuccess) { fprintf(stderr, "kernel_launch: hipFuncSetAttribute failed\n"); grid = -1; return; }
        if (hipOccupancyMaxActiveBlocksPerMultiprocessor(&per_cu, (const void*)mega_fwd, NWAVES * 64, LDS_BYTES) != hipSuccess || per_cu < 1) fprintf(stderr, "kernel_launch: occupancy query says %d\n", per_cu);
        (void)hipGetLastError();
        grid = cus;
    }
    if (grid < 0) return;
    (void)hipMemsetAsync((char*)d_ws + WS_CTL, 0, CTL_ZERO_BYTES, stream);
    Args a{};
    for (int i = 0; i < 16; ++i) a.in[i] = (const float*)d_in[i];
    a.out = (float*)d_out; a.ws = (unsigned char*)d_ws;
    for (int i = 0; i < 8; ++i) a.invA[i] = powf(500000.0f, -((float)i * 2.0f / 16.0f));
    for (int i = 0; i < 16; ++i) a.invB[i] = powf(10000.0f, -((float)i * 2.0f / 32.0f));
    if (N_LAUNCHES == 1) { a.ph_lo = 0; a.ph_hi = N_PHASES; hipLaunchKernelGGL(mega_fwd, dim3(grid), dim3(NWAVES * 64), LDS_BYTES, stream, a); }
    else for (int p = 0; p < N_PHASES; ++p) { a.ph_lo = p; a.ph_hi = p + 1; hipLaunchKernelGGL(mega_fwd, dim3(grid), dim3(NWAVES * 64), LDS_BYTES, stream, a); }
}
```

```cpp
#include <hip/hip_runtime.h>
#include <hip/hip_bf16.h>
#include <cstdio>
#include <cstdint>
#include <cmath>

#ifndef MK_N_LAUNCHES
#define MK_N_LAUNCHES 1
#endif

#define LAS __attribute__((address_space(3)))
#define GAS __attribute__((address_space(1)))
typedef unsigned short bf16_t;
typedef short bf16x8 __attribute__((ext_vector_type(8)));
typedef short s16x4 __attribute__((ext_vector_type(4)));
typedef float f32x4 __attribute__((ext_vector_type(4)));
typedef float f32x16 __attribute__((ext_vector_type(16)));
typedef unsigned u32x4 __attribute__((ext_vector_type(4)));
typedef unsigned u32x2 __attribute__((ext_vector_type(2)));
typedef float f32x2_t __attribute__((ext_vector_type(2)));
typedef __bf16 bf16x2_t __attribute__((ext_vector_type(2)));

constexpr int SEQ = 8192, NB = 2, M = NB * SEQ, DM = 1024, FF = 4096;
constexpr int IN_TOTAL = 5152;
constexpr int NPROJ = 5376;
constexpr int LD_QKVA = 2304, LD_QC = 512, LD_KVC = 256, LD_G = 2048, LD_KPE = 32, LD_MQ = 768, LD_MKV = 1024, LD_MIX = 768;
constexpr float EPS = 1e-6f;
constexpr float LOG2E = 1.4426950408889634f;
constexpr float QSCALE_A = 0.125f * LOG2E;
constexpr float QSCALE_B = 0.10206207261596577f * LOG2E;

constexpr size_t MiB = 1u << 20;
constexpr size_t WS_CTL = 0, CTL_ZERO_BYTES = 64 * 1024;
constexpr size_t WS_WIN = 256 * 1024;
constexpr size_t WS_WUQ = WS_WIN + (size_t)NPROJ * 1024 * 2;
constexpr size_t WS_WUKV = WS_WUQ + (size_t)768 * 512 * 2;
constexpr size_t WS_WO = WS_WUKV + (size_t)1024 * 256 * 2;
constexpr size_t WS_WOUT = WS_WO + (size_t)1024 * 768 * 2;
constexpr size_t WS_WF1 = WS_WOUT + (size_t)1024 * 1024 * 2;
constexpr size_t WS_WF2 = WS_WF1 + (size_t)4096 * 1024 * 2;
constexpr size_t WS_CSA = WS_WF2 + (size_t)4096 * 1024 * 2;
constexpr size_t WS_CSB = WS_CSA + (size_t)8192 * 16 * 4;
constexpr size_t WS_SSQ = WS_CSB + (size_t)8192 * 32 * 4;
constexpr size_t WS_WEND = WS_SSQ + (size_t)M * 16 * 4;
static_assert(WS_WEND <= 34 * MiB, "weights region");
constexpr size_t WS_XN = 34 * MiB;
constexpr size_t WS_QKVA = 66 * MiB;
constexpr size_t WS_QC = 138 * MiB;
constexpr size_t WS_KVC = 154 * MiB;
constexpr size_t WS_KPE = 162 * MiB;
constexpr size_t WS_MQ = 163 * MiB;
constexpr size_t WS_MIX = 187 * MiB;
constexpr size_t WS_U = 211 * MiB;
constexpr size_t WS_F32 = 66 * MiB;
constexpr size_t WS_HN = 224 * MiB;
constexpr size_t WS_HID = 34 * MiB;
constexpr size_t WS_FFO = 162 * MiB;
static_assert(WS_U + (size_t)M * 1024 * 2 <= 256 * MiB && WS_HN + (size_t)M * 1024 * 2 <= 256 * MiB, "ws");

namespace pg8 {
constexpr int BM = 256, BK = 64, HALF = 128, HTB = HALF * BK * 2, STAGE_BYTES = 8 * HTB, NXCD = 8, WGM = 8;
__host__ __device__ __forceinline__ int lds_byte(int r, int c) { const int st = (r >> 4) * 2 + (c >> 5), rr = r & 15, cc = c & 31, ob = rr * 64 + cc * 2; return st * 1024 + (ob ^ (((ob >> 9) & 1) << 5)); }
__host__ __device__ __forceinline__ void stage_rc(int b, int& R, int& C) { const int st = b / 1024, sb = b % 1024, swz = sb ^ (((sb >> 9) & 1) << 5); R = (st >> 1) * 16 + swz / 64; C = (st & 1) * 32 + (swz % 64) / 2; }
__host__ __device__ __forceinline__ int perm32(int rho) { const int n = rho >> 4, i = rho & 15; return 8 * (i >> 2) + 4 * n + (i & 3); }
struct Unit { int pm, pn; };
struct Gemm { const bf16_t* A; const bf16_t* Bt; int lda, ldb, K; };
struct StaticOrder {
    int nM, nN, nwg, G, c;
    __device__ void init(int M_, int N_, int G_, int c_) { nM = M_ / BM; nN = N_ / BM; nwg = nM * nN; G = G_; c = c_; }
    __device__ bool next(int i, Unit& u) const {
        const long L = (long)i * G + c; if (L >= nwg) return false;
        int wgid = (int)L; { const int q = nwg / NXCD, r = nwg % NXCD, xcd = wgid % NXCD, off = wgid / NXCD; wgid = (xcd < r ? xcd * (q + 1) : r * (q + 1) + (xcd - r) * q) + off; }
        const int nig = WGM * nN, gid = wgid / nig, fm = gid * WGM, gsz = (nM - fm) < WGM ? (nM - fm) : WGM;
        u.pm = fm + ((wgid % nig) % gsz); u.pn = (wgid % nig) / gsz; return true;
    }
};
__device__ __forceinline__ unsigned cvt_pk_bf16(float lo, float hi) { f32x2_t v = {lo, hi}; bf16x2_t b = __builtin_convertvector(v, bf16x2_t); return __builtin_bit_cast(unsigned, b); }
__device__ __forceinline__ float bf_lo(unsigned w) { return __uint_as_float(w << 16); }
__device__ __forceinline__ float bf_hi(unsigned w) { return __uint_as_float(w & 0xffff0000u); }

struct EpiArgs {
    bf16_t *o0, *o1, *o2, *o3, *o4;
    float* f0; float* ssq; const float* bias; const float* csa; const float* csb; const bf16_t* gates;
};
template <int MODE> struct Epi {
    static constexpr bool PERM = true;
    EpiArgs a;
    __device__ __forceinline__ void store8(bf16_t* p, const float (&v)[8]) const {
        u32x4 w; w.x = cvt_pk_bf16(v[0], v[1]); w.y = cvt_pk_bf16(v[2], v[3]); w.z = cvt_pk_bf16(v[4], v[5]); w.w = cvt_pk_bf16(v[6], v[7]); *(u32x4*)p = w;
    }
    __device__ __forceinline__ void operator()(const f32x4 (&acc)[2][2][4][2], const Unit& u, int wr, int wc, int fr, int fq) const {
        const int pn = u.pn;
#pragma unroll
        for (int ai = 0; ai < 2; ++ai)
#pragma unroll
            for (int m = 0; m < 4; ++m) {
                const int row = u.pm * BM + ai * HALF + wr * 64 + m * 16 + fr;
                const int pos = row & (SEQ - 1);
                float rs = 1.f;
                if (MODE == 1) { const f32x4 s0 = *(const f32x4*)(a.ssq + (size_t)row * 16), s1 = *(const f32x4*)(a.ssq + (size_t)row * 16 + 4);
                    const float s = ((s0[0] + s0[1]) + (s0[2] + s0[3])) + ((s1[0] + s1[1]) + (s1[2] + s1[3])); rs = __builtin_amdgcn_rsqf(s * (1.f / 512.f) + EPS) * QSCALE_B; }
                if (MODE == 2) { const f32x4 s0 = *(const f32x4*)(a.ssq + (size_t)row * 16 + 8); const float s = (s0[0] + s0[1]) + (s0[2] + s0[3]); rs = __builtin_amdgcn_rsqf(s * (1.f / 256.f) + EPS); }
                float sq = 0.f;
#pragma unroll
                for (int bj = 0; bj < 2; ++bj) {
                    const int ct = bj * HALF + wc * 32 + 8 * fq;
                    float v[8];
#pragma unroll
                    for (int j = 0; j < 4; ++j) { v[j] = acc[ai][bj][m][0][j]; v[4 + j] = acc[ai][bj][m][1][j]; }
                    if (MODE == 0) {
                        if (pn < 6) {
                            if ((wc & 1) == 0) {
                                float c[8], s[8];
                                if (fq < 2) {
#pragma unroll
                                    for (int j = 0; j < 8; j += 4) { const f32x4 cc = *(const f32x4*)(a.csa + pos * 16 + j), ss = *(const f32x4*)(a.csa + pos * 16 + 8 + j);
#pragma unroll
                                        for (int e = 0; e < 4; ++e) { c[j + e] = cc[e]; s[j + e] = ss[e]; } }
                                } else {
#pragma unroll
                                    for (int j = 0; j < 8; ++j) { c[j] = 1.f; s[j] = 0.f; }
                                }
                                const float sg = (fq == 0) ? -1.f : 1.f;
#pragma unroll
                                for (int j = 0; j < 8; ++j) { const float p = __shfl_xor(v[j], 16); v[j] = v[j] * c[j] + sg * p * s[j]; }
                            }
                            if (pn < 3) {
#pragma unroll
                                for (int j = 0; j < 8; ++j) v[j] *= QSCALE_A;
                            }
                            store8(a.o0 + (size_t)row * LD_QKVA + pn * BM + ct, v);
                        } else if (pn < 9) {
                            store8(a.o0 + (size_t)row * LD_QKVA + pn * BM + ct, v);
                        } else if (pn < 12) {
#pragma unroll
                            for (int j = 0; j < 8; ++j) sq += v[j] * v[j];
                            if (pn < 11) store8(a.o1 + (size_t)row * LD_QC + (pn - 9) * BM + ct, v);
                            else store8(a.o2 + (size_t)row * LD_KVC + ct, v);
                        } else if (pn < 20) {
                            const int gc = (pn - 12) * BM + ct;
                            const f32x4 b0 = *(const f32x4*)(a.bias + gc), b1 = *(const f32x4*)(a.bias + gc + 4);
#pragma unroll
                            for (int j = 0; j < 4; ++j) { v[j] = __builtin_amdgcn_rcpf(1.f + __builtin_amdgcn_exp2f(-(v[j] + b0[j]) * LOG2E)); v[4 + j] = __builtin_amdgcn_rcpf(1.f + __builtin_amdgcn_exp2f(-(v[4 + j] + b1[j]) * LOG2E)); }
                            store8(a.o3 + (size_t)row * LD_G + gc, v);
                        } else {
                            if (wc == 0 && bj == 0) {
                                const int fi = 8 * (fq & 1);
                                const float sg = (fq < 2) ? -1.f : 1.f;
#pragma unroll
                                for (int j = 0; j < 8; ++j) { const float p = __shfl_xor(v[j], 32); const float c = a.csb[pos * 32 + fi + j], s = a.csb[pos * 32 + 16 + fi + j]; v[j] = v[j] * c + sg * p * s; }
                                store8(a.o4 + (size_t)row * LD_KPE + 8 * fq, v);
                            }
                        }
                    } else if (MODE == 1) {
#pragma unroll
                        for (int j = 0; j < 8; ++j) v[j] *= rs;
                        const int g32 = 8 * pn + 4 * bj + wc;
                        if ((g32 % 3) == 2) {
                            const int fi = 8 * (fq & 1);
                            const float sg = (fq < 2) ? -1.f : 1.f;
#pragma unroll
                            for (int j = 0; j < 8; ++j) { const float p = __shfl_xor(v[j], 32); const float c = a.csb[pos * 32 + fi + j], s = a.csb[pos * 32 + 16 + fi + j]; v[j] = v[j] * c + sg * p * s; }
                        }
                        store8(a.o0 + (size_t)row * LD_MQ + pn * BM + ct, v);
                    } else if (MODE == 2) {
#pragma unroll
                        for (int j = 0; j < 8; ++j) v[j] *= rs;
                        store8(a.o0 + (size_t)row * LD_MKV + pn * BM + ct, v);
                    } else if (MODE == 3 || MODE == 4) {
                        const int col = pn * BM + ct;
                        const u32x4 g = *(const u32x4*)(a.gates + (size_t)row * LD_G + (MODE == 4 ? 1024 : 0) + col);
                        float gg[8] = {bf_lo(g.x), bf_hi(g.x), bf_lo(g.y), bf_hi(g.y), bf_lo(g.z), bf_hi(g.z), bf_lo(g.w), bf_hi(g.w)};
                        bf16_t* up = a.o0 + (size_t)row * 1024 + col;
                        if (MODE == 4) { const u32x4 o = *(const u32x4*)up; const float oo[8] = {bf_lo(o.x), bf_hi(o.x), bf_lo(o.y), bf_hi(o.y), bf_lo(o.z), bf_hi(o.z), bf_lo(o.w), bf_hi(o.w)};
#pragma unroll
                            for (int j = 0; j < 8; ++j) v[j] = oo[j] + gg[j] * v[j];
                        } else {
#pragma unroll
                            for (int j = 0; j < 8; ++j) v[j] = gg[j] * v[j];
                        }
                        store8(up, v);
                    } else if (MODE == 5) {
#pragma unroll
                        for (int j = 0; j < 8; ++j) sq += v[j] * v[j];
                        float* op = a.f0 + (size_t)row * 1024 + pn * BM + ct;
                        *(f32x4*)op = (f32x4){v[0], v[1], v[2], v[3]}; *(f32x4*)(op + 4) = (f32x4){v[4], v[5], v[6], v[7]};
                    } else if (MODE == 6) {
#pragma unroll
                        for (int j = 0; j < 8; ++j) { const float r = fmaxf(v[j], 0.f); v[j] = r * r; }
                        store8(a.o0 + (size_t)row * FF + pn * BM + ct, v);
                    }
                }
                if (MODE == 3 || MODE == 4) asm volatile("" ::: "memory");
                if (MODE == 5 || (MODE == 0 && pn >= 9 && pn < 12)) {
                    sq += __shfl_xor(sq, 16); sq += __shfl_xor(sq, 32);
                    const int slot = (MODE == 5) ? (pn * 4 + wc) : ((pn - 9) * 4 + wc);
                    if (fq == 0) a.ssq[(size_t)row * 16 + slot] = sq;
                }
            }
    }
};

template <class EpiT>
__device__ __forceinline__ void gemm_phase(LAS unsigned char* lds, const Gemm g, const StaticOrder& S, const EpiT& E) {
    const int tid = threadIdx.x, wid = __builtin_amdgcn_readfirstlane(tid >> 6), lane = tid & 63, wr = wid >> 2, wc = wid & 3, fr = lane & 15, fq = lane >> 4;
    int nt = g.K / BK; asm volatile("" : "+s"(nt));
    unsigned voffA[2], voffB[2];
#pragma unroll
    for (int i = 0; i < 2; ++i) { int R, C; stage_rc(tid * 16 + i * 8192, R, C); const int Rb = EpiT::PERM ? ((R & ~31) + perm32(R & 31)) : R;
        voffA[i] = (unsigned)(R * g.lda + C) * 2u; voffB[i] = (unsigned)(Rb * g.ldb + C) * 2u; }
    const size_t kstep = (size_t)(BK * 2);
    const size_t hstepA = (size_t)HALF * g.lda * 2, hstepB = (size_t)HALF * g.ldb * 2;
    const size_t tstepA = 2 * hstepA, tstepB = 2 * hstepB;
    const unsigned ldsw = (unsigned)wid * 1024u;
    const int aoff = lds_byte(wr * 64 + fr, fq * 8), boff = lds_byte(wc * 32 + fr, fq * 8);
#define PG8_SA(b, h) (((b) * 2 + (h)) * HTB)
#define PG8_SB(b, h) ((4 + (b) * 2 + (h)) * HTB)
#define PG8_STAGE(bufoff, gbase, voff) do { _Pragma("unroll") for (int _i = 0; _i < 2; ++_i) \
        __builtin_amdgcn_global_load_lds((const unsigned*)((const char*)(gbase) + (voff)[_i]), (LAS unsigned*)(lds + (bufoff) + ldsw + _i * 8192), 16, 0, 0); } while (0)
#define PG8_LDA(dst, b, h) do { _Pragma("unroll") for (int m = 0; m < 4; ++m) _Pragma("unroll") for (int k = 0; k < 2; ++k) dst[m][k] = *(const LAS bf16x8*)(lds + PG8_SA(b, h) + aoff + m * 2048 + k * 1024); } while (0)
#define PG8_LDB(dst, b, h) do { _Pragma("unroll") for (int n = 0; n < 2; ++n) _Pragma("unroll") for (int k = 0; k < 2; ++k) dst[n][k] = *(const LAS bf16x8*)(lds + PG8_SB(b, h) + boff + n * 2048 + k * 1024); } while (0)
#define PG8_MMA(ai, bj, At, Bt) do { __builtin_amdgcn_s_setprio(1); _Pragma("unroll") for (int m = 0; m < 4; ++m) _Pragma("unroll") for (int n = 0; n < 2; ++n) _Pragma("unroll") for (int k = 0; k < 2; ++k) \
        acc[ai][bj][m][n] = __builtin_amdgcn_mfma_f32_16x16x32_bf16(Bt[n][k], At[m][k], acc[ai][bj][m][n], 0, 0, 0); __builtin_amdgcn_s_setprio(0); } while (0)
#define PG8_WAIT_V(n) asm volatile("s_waitcnt vmcnt(" #n ")" ::: "memory")
#define PG8_WAIT_L(n) asm volatile("s_waitcnt lgkmcnt(" #n ")" ::: "memory")
#define PG8_BAR __builtin_amdgcn_s_barrier()
#define PG8_SCHED __builtin_amdgcn_sched_barrier(0)
    Unit cur, nxt; int ui = 0;
    if (!S.next(0, cur)) return;
    f32x4 acc[2][2][4][2];
#pragma unroll
    for (int a = 0; a < 2; ++a)
#pragma unroll
        for (int b = 0; b < 2; ++b)
#pragma unroll
            for (int m = 0; m < 4; ++m)
#pragma unroll
                for (int n = 0; n < 2; ++n) acc[a][b][m][n] = (f32x4){0.f, 0.f, 0.f, 0.f};
    bf16x8 At[4][2], B0[2][2], B1[2][2];
    const char* cA = (const char*)g.A + (size_t)cur.pm * tstepA; const char* cB = (const char*)g.Bt + (size_t)cur.pn * tstepB;
    PG8_STAGE(PG8_SB(0, 0), cB, voffB); PG8_STAGE(PG8_SB(0, 1), cB + hstepB, voffB); PG8_STAGE(PG8_SA(0, 0), cA, voffA); PG8_STAGE(PG8_SA(0, 1), cA + hstepA, voffA);
    if (wr == 1) PG8_BAR;
    PG8_WAIT_V(2); PG8_BAR;
    PG8_STAGE(PG8_SB(1, 0), cB + kstep, voffB); PG8_STAGE(PG8_SA(1, 0), cA + kstep, voffA); PG8_STAGE(PG8_SB(1, 1), cB + hstepB + kstep, voffB);
    PG8_WAIT_V(6); PG8_BAR;
    for (;;) {
        const bool has_next = S.next(ui + 1, nxt);
        const char* nA = has_next ? (const char*)g.A + (size_t)nxt.pm * tstepA : cA; const char* nB = has_next ? (const char*)g.Bt + (size_t)nxt.pn * tstepB : cB;
        for (int t = 0; t < nt; t += 2) {
            const bool last = (t == nt - 2);
            const char* a1 = cA + (size_t)(t + 1) * kstep;
            const char* a2 = last ? nA : cA + (size_t)(t + 2) * kstep; const char* b2 = last ? nB : cB + (size_t)(t + 2) * kstep;
            const char* a3 = a2 + kstep; const char* b3 = b2 + kstep;
            PG8_LDB(B0, 0, 0); PG8_LDB(B1, 0, 1); PG8_SCHED; PG8_LDA(At, 0, 0); PG8_STAGE(PG8_SA(1, 1), a1 + hstepA, voffA);
            PG8_WAIT_V(8); PG8_WAIT_L(0); PG8_BAR; PG8_MMA(0, 0, At, B0); PG8_MMA(0, 1, At, B1); PG8_BAR; PG8_SCHED;
            PG8_LDA(At, 0, 1); PG8_STAGE(PG8_SB(0, 0), b2, voffB); PG8_STAGE(PG8_SB(0, 1), b2 + hstepB, voffB); PG8_STAGE(PG8_SA(0, 0), a2, voffA);
            PG8_WAIT_V(8); PG8_WAIT_L(0); PG8_BAR; PG8_MMA(1, 0, At, B0); PG8_MMA(1, 1, At, B1); PG8_BAR; PG8_SCHED;
            PG8_LDB(B0, 1, 0); PG8_LDB(B1, 1, 1); PG8_SCHED; PG8_LDA(At, 1, 0); PG8_STAGE(PG8_SA(0, 1), a2 + hstepA, voffA);
            PG8_WAIT_V(8); PG8_WAIT_L(0); PG8_BAR; PG8_MMA(0, 0, At, B0); PG8_MMA(0, 1, At, B1); PG8_BAR; PG8_SCHED;
            PG8_LDA(At, 1, 1); PG8_STAGE(PG8_SB(1, 0), b3, voffB); PG8_STAGE(PG8_SB(1, 1), b3 + hstepB, voffB); PG8_STAGE(PG8_SA(1, 0), a3, voffA);
            PG8_WAIT_V(8); PG8_WAIT_L(0); PG8_BAR; PG8_MMA(1, 0, At, B0); PG8_MMA(1, 1, At, B1); PG8_BAR; PG8_SCHED;
        }
        if (wr == 0) PG8_BAR;
        E(acc, cur, wr, wc, fr, fq);
        if (!has_next) break;
#pragma unroll
        for (int a = 0; a < 2; ++a)
#pragma unroll
            for (int b = 0; b < 2; ++b)
#pragma unroll
                for (int m = 0; m < 4; ++m)
#pragma unroll
                    for (int n = 0; n < 2; ++n) acc[a][b][m][n] = (f32x4){0.f, 0.f, 0.f, 0.f};
        cur = nxt; cA = nA; cB = nB; ++ui;
        if (wr == 1) PG8_BAR;
    }
    PG8_WAIT_V(0);
    PG8_BAR;
#undef PG8_SA
#undef PG8_SB
#undef PG8_STAGE
#undef PG8_LDA
#undef PG8_LDB
#undef PG8_MMA
#undef PG8_WAIT_V
#undef PG8_WAIT_L
#undef PG8_BAR
#undef PG8_SCHED
}
}

namespace att {
typedef LAS const char* lds_cptr;
typedef short v4i16_t __attribute__((ext_vector_type(4)));
__device__ __forceinline__ int crow(int r, int hi) { return (r & 3) + 8 * (r >> 2) + 4 * hi; }
__device__ __forceinline__ void glds16(const void* gsrc, unsigned lds_dst) { unsigned keep;
    asm volatile("s_mov_b32 %0, m0\n\ts_mov_b32 m0, %2\n\ts_nop 0\n\tglobal_load_lds_dwordx4 %1, off\n\ts_mov_b32 m0, %0" : "=&s"(keep) : "v"(gsrc), "s"(lds_dst) : "memory"); }
__device__ __forceinline__ unsigned cvtpk(float lo, float hi) { return pg8::cvt_pk_bf16(lo, hi); }
__device__ __forceinline__ s16x4 vtr(lds_cptr p) { return __builtin_bit_cast(s16x4, __builtin_amdgcn_ds_read_tr16_b64_v4i16((LAS v4i16_t*)p)); }
__device__ __forceinline__ float halfmax(float m) { auto rr = __builtin_amdgcn_permlane32_swap(__float_as_uint(m), __float_as_uint(m), false, false); return fmaxf(__uint_as_float(rr[0]), __uint_as_float(rr[1])); }
__device__ __forceinline__ float halfsum(float m) { auto rr = __builtin_amdgcn_permlane32_swap(__float_as_uint(m), __float_as_uint(m), false, false); return __uint_as_float(rr[0]) + __uint_as_float(rr[1]); }
#define WAIT_BAR(N) asm volatile("s_waitcnt vmcnt(" #N ") lgkmcnt(0)\n\ts_barrier" ::: "memory")
#define VFRAG(lo, hi) (bf16x8){lo[0], lo[1], lo[2], lo[3], hi[0], hi[1], hi[2], hi[3]}

constexpr int NSLOT = 4, KSLOT = 12288, VSLOT = 8192;
constexpr int LDS_K = 0, LDS_V = NSLOT * KSLOT, LDS_OST = LDS_V + NSLOT * VSLOT, OST_W = 32 * 144, LDS_END = LDS_OST + 8 * OST_W;
static_assert(LDS_END <= 131072, "attention LDS");
constexpr float PBIG = 4096.f;

__device__ __forceinline__ void mla_unit(int b, int h, int qb, const bf16_t* MQ, const bf16_t* MKV, const bf16_t* KPE, bf16_t* MIX, LAS unsigned char* shm) {
    const int tid = threadIdx.x, lane = tid & 63, r32 = lane & 31, hi = lane >> 5; const int wid = __builtin_amdgcn_readfirstlane(tid >> 6);
    const long rowbase = (long)b * SEQ; const int q0 = qb * 256;
    const bf16_t* Qw = MQ + (rowbase + q0 + wid * 32) * LD_MQ + h * 96;
    const unsigned lds0 = (unsigned)(uintptr_t)shm;
    const bf16_t* ksrc0 = MKV + (rowbase + lane) * LD_MKV + h * 128 + wid * 8;
    const bf16_t* ksrc1 = KPE + (rowbase + lane) * LD_KPE + (wid & 3) * 8;
    const bf16_t* vsrc = MKV + (rowbase + 16 * (wid & 3) + (lane >> 2)) * LD_MKV + h * 128 + 64 + (wid >> 2) * 32 + (lane & 3) * 8;
    const unsigned kdst0 = lds0 + LDS_K + wid * 1024, kdst1 = lds0 + LDS_K + (8 + (wid & 3)) * 1024, vdst = lds0 + LDS_V + wid * 1024;
#define DMA_T(t, s) do { glds16(ksrc0 + (long)(t) * 64 * LD_MKV, (unsigned)__builtin_amdgcn_readfirstlane(kdst0 + (s) * KSLOT)); \
                         glds16(ksrc1 + (long)(t) * 64 * LD_KPE, (unsigned)__builtin_amdgcn_readfirstlane(kdst1 + (s) * KSLOT)); \
                         glds16(vsrc + (long)(t) * 64 * LD_MKV, (unsigned)__builtin_amdgcn_readfirstlane(vdst + (s) * VSLOT)); } while (0)
    const lds_cptr shm3 = (lds_cptr)shm;
    const lds_cptr kp0 = shm3 + LDS_K + hi * 1024 + r32 * 16;
    const lds_cptr vp0 = shm3 + LDS_V + ((lane >> 4) & 1) * 32 + (lane & 3) * 8 + (4 * hi + ((lane & 15) >> 2)) * 64;
    constexpr int NT = SEQ / 64;
    DMA_T(0, 0); DMA_T(1, 1); DMA_T(2, 2);
    bf16x8 qr[6];
#pragma unroll
    for (int d0 = 0; d0 < 6; ++d0) qr[d0] = *(const bf16x8*)(Qw + (long)r32 * LD_MQ + d0 * 16 + hi * 8);
    asm volatile("s_waitcnt vmcnt(0)" ::: "memory");
#pragma unroll
    for (int d0 = 0; d0 < 6; ++d0) asm volatile("" : "+v"(qr[d0]));
    __builtin_amdgcn_s_barrier();
    float mhat = 0.f, l_reg = 0.f; f32x16 o[2]; o[0] = f32x16{}; o[1] = f32x16{}; f32x16 negm = f32x16{};
    bf16x8 kf[12]; u32x4 pw[4]; s16x4 vlo[8], vhi[8];
#define SB() __builtin_amdgcn_sched_barrier(0)
#define MF(D, A, B, C) D = __builtin_amdgcn_mfma_f32_32x32x16_bf16(A, B, C, 0, 0, 0)
#define MLA_KF(off) do { const lds_cptr kp_ = kp0 + (off); _Pragma("unroll") for (int d0 = 0; d0 < 6; ++d0) { kf[2 * d0] = *(const LAS bf16x8*)(kp_ + d0 * 2048); kf[2 * d0 + 1] = *(const LAS bf16x8*)(kp_ + d0 * 2048 + 512); } } while (0)
#define GA(P0, P1, j) do { sa0 += P0[2 * (j)]; sa1 += P0[2 * (j) + 1]; sa2 += P1[2 * (j)]; sa3 += P1[2 * (j) + 1]; \
        pw[(j) >> 2][(j) & 3] = cvtpk(P0[2 * (j)], P0[2 * (j) + 1]); pw[2 + ((j) >> 2)][(j) & 3] = cvtpk(P1[2 * (j)], P1[2 * (j) + 1]); } while (0)
#define EX4(X, B) do { X[B] = __builtin_amdgcn_exp2f(X[B]); X[B + 1] = __builtin_amdgcn_exp2f(X[B + 1]); X[B + 2] = __builtin_amdgcn_exp2f(X[B + 2]); X[B + 3] = __builtin_amdgcn_exp2f(X[B + 3]); } while (0)
#define PAF(k) __builtin_bit_cast(bf16x8, pw[k])
#define QK12(N0, N1, CI) do { MF(N0, kf[0], qr[0], CI); MF(N1, kf[1], qr[0], CI); _Pragma("unroll") for (int d0 = 1; d0 < 6; ++d0) { MF(N0, kf[2 * d0], qr[d0], N0); MF(N1, kf[2 * d0 + 1], qr[d0], N1); } } while (0)
#define RARE(P0, P1, N0, N1, tt, HASN) do { MLA_KF(((tt) & 3) * KSLOT); f32x16 R0, R1; QK12(R0, R1, negm); \
        float rm_ = fmaxf(R0[0], R1[0]); _Pragma("unroll") for (int r = 1; r < 16; ++r) rm_ = fmaxf(rm_, fmaxf(R0[r], R1[r])); rm_ = halfmax(rm_); \
        const float dl_ = fmaxf(rm_, 0.f), f_ = __builtin_amdgcn_exp2f(-dl_); mhat += dl_; l_reg *= f_; \
        _Pragma("unroll") for (int r = 0; r < 16; ++r) { o[0][r] *= f_; o[1][r] *= f_; negm[r] = -mhat; P0[r] = __builtin_amdgcn_exp2f(R0[r] - dl_); P1[r] = __builtin_amdgcn_exp2f(R1[r] - dl_); if (HASN) { N0[r] -= dl_; N1[r] -= dl_; } } \
        sa0 = 0.f; sa1 = 0.f; sa2 = 0.f; sa3 = 0.f; _Pragma("unroll") for (int j = 0; j < 8; ++j) GA(P0, P1, j); sacc = (sa0 + sa1) + (sa2 + sa3); } while (0)
#define VREADS(tt) do { const lds_cptr vp_ = vp0 + ((tt) & 3) * VSLOT; _Pragma("unroll") for (int i = 0; i < 8; ++i) { vlo[i] = vtr(vp_ + (i >> 2) * 4096 + (i & 3) * 1024); vhi[i] = vtr(vp_ + (i >> 2) * 4096 + (i & 3) * 1024 + 512); } } while (0)
#define VF(i) VFRAG(vlo[i], vhi[i])
#define STEP(P0, P1, N0, N1, tt) do { \
        WAIT_BAR(3); \
        if ((tt) + 3 < NT) DMA_T((tt) + 3, ((tt) + 3) & 3); \
        MLA_KF((((tt) + 1) & 3) * KSLOT); \
        float sa0 = 0.f, sa1 = 0.f, sa2 = 0.f, sa3 = 0.f, sacc; SB(); \
        MF(N0, kf[0], qr[0], negm); GA(P0, P1, 0); SB(); \
        MF(N1, kf[1], qr[0], negm); GA(P0, P1, 1); SB(); \
        MF(N0, kf[2], qr[1], N0);   GA(P0, P1, 2); SB(); \
        MF(N1, kf[3], qr[1], N1);   GA(P0, P1, 3); SB(); \
        MF(N0, kf[4], qr[2], N0);   GA(P0, P1, 4); SB(); \
        MF(N1, kf[5], qr[2], N1);   GA(P0, P1, 5); SB(); \
        MF(N0, kf[6], qr[3], N0);   GA(P0, P1, 6); SB(); \
        MF(N1, kf[7], qr[3], N1);   GA(P0, P1, 7); SB(); \
        MF(N0, kf[8], qr[4], N0); MF(N1, kf[9], qr[4], N1); MF(N0, kf[10], qr[5], N0); MF(N1, kf[11], qr[5], N1); \
        sacc = (sa0 + sa1) + (sa2 + sa3); SB(); \
        if (__builtin_expect(__any(sacc > PBIG), 0)) { RARE(P0, P1, N0, N1, tt, true); } \
        l_reg += sacc; \
        VREADS(tt); SB(); \
        MF(o[0], VF(0), PAF(0), o[0]); EX4(N0, 0);  SB(); \
        MF(o[1], VF(4), PAF(0), o[1]); EX4(N0, 4);  SB(); \
        MF(o[0], VF(1), PAF(1), o[0]); EX4(N0, 8);  SB(); \
        MF(o[1], VF(5), PAF(1), o[1]); EX4(N0, 12); SB(); \
        MF(o[0], VF(2), PAF(2), o[0]); EX4(N1, 0);  SB(); \
        MF(o[1], VF(6), PAF(2), o[1]); EX4(N1, 4);  SB(); \
        MF(o[0], VF(3), PAF(3), o[0]); EX4(N1, 8);  SB(); \
        MF(o[1], VF(7), PAF(3), o[1]); EX4(N1, 12); SB(); \
    } while (0)
    f32x16 pA0, pA1, pB0, pB1;
    { MLA_KF(0); QK12(pA0, pA1, negm);
      float rm = fmaxf(pA0[0], pA1[0]);
#pragma unroll
      for (int r = 1; r < 16; ++r) rm = fmaxf(rm, fmaxf(pA0[r], pA1[r]));
      rm = halfmax(rm); mhat = rm;
#pragma unroll
      for (int r = 0; r < 16; ++r) { negm[r] = -mhat; pA0[r] = __builtin_amdgcn_exp2f(pA0[r] - rm); pA1[r] = __builtin_amdgcn_exp2f(pA1[r] - rm); } }
    int t = 0;
#pragma unroll 1
    for (; t < NT - 2; t += 2) { STEP(pA0, pA1, pB0, pB1, t); STEP(pB0, pB1, pA0, pA1, t + 1); }
    { WAIT_BAR(0);
      MLA_KF(((NT - 1) & 3) * KSLOT);
      float sa0 = 0.f, sa1 = 0.f, sa2 = 0.f, sa3 = 0.f, sacc;
      QK12(pB0, pB1, negm);
#pragma unroll
      for (int j = 0; j < 8; ++j) GA(pA0, pA1, j);
      sacc = (sa0 + sa1) + (sa2 + sa3);
      if (__builtin_expect(__any(sacc > PBIG), 0)) { RARE(pA0, pA1, pB0, pB1, NT - 2, true); }
      l_reg += sacc;
      VREADS(NT - 2);
#pragma unroll
      for (int ks = 0; ks < 4; ++ks) { MF(o[0], VF(ks), PAF(ks), o[0]); MF(o[1], VF(4 + ks), PAF(ks), o[1]); }
      EX4(pB0, 0); EX4(pB0, 4); EX4(pB0, 8); EX4(pB0, 12); EX4(pB1, 0); EX4(pB1, 4); EX4(pB1, 8); EX4(pB1, 12); }
    { float sa0 = 0.f, sa1 = 0.f, sa2 = 0.f, sa3 = 0.f, sacc;
#pragma unroll
      for (int j = 0; j < 8; ++j) GA(pB0, pB1, j);
      sacc = (sa0 + sa1) + (sa2 + sa3);
      if (__builtin_expect(__any(sacc > PBIG), 0)) { RARE(pB0, pB1, pA0, pA1, NT - 1, false); }
      l_reg += sacc;
      VREADS(NT - 1);
#pragma unroll
      for (int ks = 0; ks < 4; ++ks) { MF(o[0], VF(ks), PAF(ks), o[0]); MF(o[1], VF(4 + ks), PAF(ks), o[1]); } }
    l_reg = halfsum(l_reg);
    const float inv = 1.0f / l_reg;
    LAS unsigned char* stg = shm + LDS_OST + wid * OST_W;
#pragma unroll
    for (int d0 = 0; d0 < 2; ++d0)
#pragma unroll
        for (int rq = 0; rq < 4; ++rq) {
            u32x2 w; w.x = cvtpk(o[d0][4 * rq] * inv, o[d0][4 * rq + 1] * inv); w.y = cvtpk(o[d0][4 * rq + 2] * inv, o[d0][4 * rq + 3] * inv);
            *(LAS u32x2*)(stg + r32 * 144 + (32 * d0 + 8 * rq + 4 * hi) * 2) = w;
        }
    asm volatile("s_waitcnt lgkmcnt(0)" ::: "memory");
    bf16_t* Ow = MIX + (rowbase + q0 + wid * 32) * LD_MIX + 256 + h * 64;
#pragma unroll
    for (int i = 0; i < 4; ++i) { const int id = i * 64 + lane, row = id >> 3, ch = id & 7; const u32x4 v = *(const LAS u32x4*)(stg + row * 144 + ch * 16); *(u32x4*)(Ow + (long)row * LD_MIX + ch * 8) = v; }
    asm volatile("s_waitcnt lgkmcnt(0)\n\ts_barrier" ::: "memory");
#undef DMA_T
#undef SB
#undef MF
#undef MLA_KF
#undef GA
#undef EX4
#undef PAF
#undef QK12
#undef RARE
#undef VREADS
#undef VF
#undef STEP
}

__device__ __forceinline__ void dil_task(int b, int hg, int c5, int r, const bf16_t* QKVA, bf16_t* MIX, LAS unsigned char* vl) {
    const int lane = threadIdx.x & 63, r32 = lane & 31, hi = lane >> 5;
    const long rowb = (long)b * SEQ;
    const int tq = 512 * c5 + r + 16 * r32;
    float m = -1e30f, l = 0.f; f32x16 o[2]; o[0] = f32x16{}; o[1] = f32x16{};
    const lds_cptr vp = (lds_cptr)vl + ((lane >> 4) & 1) * 32 + (lane & 3) * 8 + (4 * hi + ((lane & 15) >> 2)) * 64;
#pragma unroll 1
    for (int g = 0; g < 3; ++g) {
        const int sh = 2 * g, d = 1 << sh, sq = 16 >> sh, L = SEQ >> sh, nblk = (g == 0) ? 20 : (g == 1 ? 8 : 5), head = 4 * g + hg;
        const int rho = r & (d - 1), lq0 = (512 * c5 + r - rho) >> sh, lk0 = lq0 - 64, lq = lq0 + sq * r32;
        const bf16_t* Kb = QKVA + 768 + head * 64 + hi * 8;
        const bf16_t* Vb = QKVA + 1536 + head * 64;
        bf16x8 qf[4];
#pragma unroll
        for (int d0 = 0; d0 < 4; ++d0) qf[d0] = *(const bf16x8*)(QKVA + (rowb + tq) * LD_QKVA + head * 64 + d0 * 16 + hi * 8);
        bf16x8 kf[4]; u32x4 vv[4];
#define DIL_LOAD(kb) do { int lk = lk0 + 32 * (kb) + r32; lk = lk < 0 ? 0 : (lk > L - 1 ? L - 1 : lk); const bf16_t* kr = Kb + (rowb + (long)lk * d + rho) * LD_QKVA; \
            _Pragma("unroll") for (int d0 = 0; d0 < 4; ++d0) kf[d0] = *(const bf16x8*)(kr + d0 * 16); \
            _Pragma("unroll") for (int ii = 0; ii < 4; ++ii) { const int id = ii * 64 + lane, key = id >> 3, c8 = id & 7; int lv = lk0 + 32 * (kb) + key; lv = lv < 0 ? 0 : (lv > L - 1 ? L - 1 : lv); \
                vv[ii] = *(const u32x4*)(Vb + (rowb + (long)lv * d + rho) * LD_QKVA + c8 * 8); } } while (0)
        DIL_LOAD(0);
#pragma unroll 1
        for (int kb = 0; kb < nblk; ++kb) {
#pragma unroll
            for (int ii = 0; ii < 4; ++ii) { const int id = ii * 64 + lane, key = id >> 3, c8 = id & 7; *(LAS u32x4*)(vl + ((c8 >> 2) * 2 + (key >> 4)) * 1024 + (key & 15) * 64 + (c8 & 3) * 16) = vv[ii]; }
            f32x16 C = f32x16{};
#pragma unroll
            for (int d0 = 0; d0 < 4; ++d0) C = __builtin_amdgcn_mfma_f32_32x32x16_bf16(kf[d0], qf[d0], C, 0, 0, 0);
            if (kb + 1 < nblk) DIL_LOAD(kb + 1);
            const int kbase = lk0 + 32 * kb;
            float rm = -INFINITY;
#pragma unroll
            for (int rr = 0; rr < 16; ++rr) { const int lk = kbase + crow(rr, hi); const int df = lq - lk; const bool ok = (lk >= 0) && (lk < L) && (df <= 64) && (df >= -64); C[rr] = ok ? C[rr] : -INFINITY; rm = fmaxf(rm, C[rr]); }
            rm = halfmax(rm);
            const float mn = fmaxf(m, rm), f = __builtin_amdgcn_exp2f(m - mn); m = mn; l *= f;
#pragma unroll
            for (int rr = 0; rr < 16; ++rr) { o[0][rr] *= f; o[1][rr] *= f; }
            float sacc = 0.f;
#pragma unroll
            for (int rr = 0; rr < 16; ++rr) { C[rr] = __builtin_amdgcn_exp2f(C[rr] - mn); sacc += C[rr]; }
            l += sacc;
            u32x4 pw[2];
#pragma unroll
            for (int k = 0; k < 4; ++k) { pw[0][k] = cvtpk(C[2 * k], C[2 * k + 1]); pw[1][k] = cvtpk(C[8 + 2 * k], C[9 + 2 * k]); }
#pragma unroll
            for (int d0 = 0; d0 < 2; ++d0)
#pragma unroll
                for (int ks = 0; ks < 2; ++ks) {
                    const s16x4 lo = vtr(vp + d0 * 2048 + ks * 1024), hh = vtr(vp + d0 * 2048 + ks * 1024 + 512);
                    o[d0] = __builtin_amdgcn_mfma_f32_32x32x16_bf16(VFRAG(lo, hh), __builtin_bit_cast(bf16x8, pw[ks]), o[d0], 0, 0, 0);
                }
        }
#undef DIL_LOAD
    }
    l = halfsum(l);
    const float inv = 1.0f / l;
    bf16_t* Ow = MIX + (rowb + tq) * LD_MIX + hg * 64;
#pragma unroll
    for (int d0 = 0; d0 < 2; ++d0)
#pragma unroll
        for (int rq = 0; rq < 4; ++rq) {
            u32x2 w; w.x = cvtpk(o[d0][4 * rq] * inv, o[d0][4 * rq + 1] * inv); w.y = cvtpk(o[d0][4 * rq + 2] * inv, o[d0][4 * rq + 3] * inv);
            *(u32x2*)(Ow + 32 * d0 + 8 * rq + 4 * hi) = w;
        }
}
#undef WAIT_BAR
#undef VFRAG
}

constexpr int NWAVES = 8;
constexpr int RING_OFF = 0, RING_BYTES = 131072;
constexpr int LDSCTL_OFF = RING_BYTES, MISC_OFF = LDSCTL_OFF + 320;
constexpr int LDS_BYTES = 147456;
constexpr int CW_BAR = 4096;
constexpr int N_PHASES = 10;
constexpr int N_LAUNCHES = MK_N_LAUNCHES;

#define XB_TMO      128
#define XB_XCNT(j)  (256  + 64 * (j))
#define XB_XSUB(j)  (1280 + 64 * (j))
#define XB_XGEN(j)  (2304 + 64 * (j))
#define XB_TOP      3328
#define XB_TOPGEN   3392
#define XCD_BAR_WORDS 3456
#define XB_SPIN_CAP (1u << 18)
static_assert((CW_BAR + XCD_BAR_WORDS) * 4 <= (int)CTL_ZERO_BYTES, "ctl");
__device__ __forceinline__ unsigned xb_ld(unsigned* p)              { return __hip_atomic_load(p, __ATOMIC_RELAXED, __HIP_MEMORY_SCOPE_AGENT); }
__device__ __forceinline__ unsigned xb_add(unsigned* p, unsigned v) { return __hip_atomic_fetch_add(p, v, __ATOMIC_RELAXED, __HIP_MEMORY_SCOPE_AGENT); }
__device__ __forceinline__ unsigned xb_xcc_id() { return (unsigned)__builtin_amdgcn_s_getreg((3 << 11) | 20) & 0xFu; }
#define XB_SPIN(cond, bar) do { unsigned _sp = 0; while (cond) { __builtin_amdgcn_s_sleep(1); \
    if ((++_sp & 255u) == 0u) { if (xb_ld(&(bar)[XB_TMO])) break; if (_sp > XB_SPIN_CAP) { atomicAdd(&(bar)[XB_TMO], 1u); break; } } } } while (0)
struct XcdBarrier { unsigned* bar; unsigned x; volatile LAS unsigned* st; };
__device__ __forceinline__ XcdBarrier xcd_barrier_post(unsigned* bar, volatile LAS unsigned* st) {
    XcdBarrier b; b.bar = bar; b.x = xb_xcc_id(); b.st = st;
    if (threadIdx.x == 0) (void)xb_add(&bar[XB_XCNT(b.x)], 1u);
    return b;
}
__device__ __forceinline__ void xcd_barrier_complete(unsigned* bar, unsigned x, unsigned& nloc, unsigned& nx) {
    const unsigned G = gridDim.x * gridDim.y * gridDim.z;
    unsigned sum, cnt, mine, sp = 0u;
    for (;;) {
        sum = 0u; cnt = 0u; mine = 0u;
#pragma unroll
        for (unsigned j = 0; j < 16; ++j) { const unsigned c = xb_ld(&bar[XB_XCNT(j)]); sum += c; cnt += (c > 0u) ? 1u : 0u; mine = (j == x) ? c : mine; }
        if (sum == G) break;
        __builtin_amdgcn_s_sleep(1);
        if ((++sp & 255u) == 0u) { if (xb_ld(&bar[XB_TMO])) break; if (sp > XB_SPIN_CAP) { atomicAdd(&bar[XB_TMO], 1u); break; } }
    }
    nloc = mine > 0u ? mine : 1u; nx = cnt > 0u ? cnt : 1u;
}
__device__ __forceinline__ void xcd_barrier(const XcdBarrier& b) {
    asm volatile("s_waitcnt vmcnt(0)" ::: "memory");
    __syncthreads();
    if (threadIdx.x == 0) {
        unsigned* bar = b.bar;
        __builtin_amdgcn_s_waitcnt(0);
        unsigned nloc = b.st[0], nx = b.st[1];
        if (nloc == 0u) { xcd_barrier_complete(bar, b.x, nloc, nx); b.st[0] = nloc; b.st[1] = nx; }
        const unsigned old = xb_add(&bar[XB_XSUB(b.x)], 1u);
        const unsigned gen = old / nloc;
        if (old + 1u == (gen + 1u) * nloc) {
            __builtin_amdgcn_fence(__ATOMIC_RELEASE, "agent");
            asm volatile("s_waitcnt vmcnt(0)" ::: "memory");
            const unsigned og = xb_add(&bar[XB_TOP], 1u);
            const unsigned tg = og / nx;
            if (og + 1u == (tg + 1u) * nx) xb_add(&bar[XB_TOPGEN], 1u);
            else XB_SPIN(xb_ld(&bar[XB_TOPGEN]) == tg, bar);
            __builtin_amdgcn_fence(__ATOMIC_ACQUIRE, "agent");
            xb_add(&bar[XB_XGEN(b.x)], 1u);
            asm volatile("s_waitcnt vmcnt(0)" ::: "memory");
        } else {
            XB_SPIN(xb_ld(&bar[XB_XGEN(b.x)]) == gen, bar);
            __builtin_amdgcn_fence(__ATOMIC_ACQUIRE, "agent");
            asm volatile("s_waitcnt vmcnt(0)" ::: "memory");
        }
    }
    __syncthreads();
}

__device__ __forceinline__ unsigned f2bf(float f) { unsigned u = __builtin_bit_cast(unsigned, f); return (u + 0x7fffu + ((u >> 16) & 1u)) >> 16; }
__device__ __forceinline__ unsigned pk2(float lo, float hi) { return f2bf(lo) | (f2bf(hi) << 16); }
__device__ __forceinline__ float wave_sum(float v) {
#pragma unroll
    for (int o = 1; o < 64; o <<= 1) v += __shfl_xor(v, o);
    return v;
}
__device__ __forceinline__ void transpose_item(const float* W, int N, bf16_t* WT, int ldk, int koff, int drow0, const float* kgain, LAS float* scr, int k0, int n0, int lane) {
#pragma unroll 8
    for (int i = 0; i < 32; ++i) { const int kk = 2 * i + (lane >> 5); float w = W[(size_t)(k0 + kk) * N + n0 + (lane & 31)]; if (kgain) w *= kgain[k0 + kk]; scr[kk * 33 + (lane & 31)] = w; }
    asm volatile("s_waitcnt lgkmcnt(0)" ::: "memory");
    const int c = lane & 7;
#pragma unroll
    for (int j = 0; j < 4; ++j) { const int n = (lane >> 3) + 8 * j; const LAS float* s = scr + (8 * c) * 33 + n;
        u32x4 o; o.x = pk2(s[0 * 33], s[1 * 33]); o.y = pk2(s[2 * 33], s[3 * 33]); o.z = pk2(s[4 * 33], s[5 * 33]); o.w = pk2(s[6 * 33], s[7 * 33]);
        *(u32x4*)(WT + (size_t)(drow0 + n) * ldk + koff + k0 + 8 * c) = o; }
    asm volatile("s_waitcnt lgkmcnt(0)" ::: "memory");
}

struct Args {
    const float* in[16]; float* out; unsigned char* ws;
    float invA[8]; float invB[16];
    int ph_lo, ph_hi;
};

__global__ void __launch_bounds__(NWAVES * 64, 2) mega_fwd(Args args) {
    extern __shared__ __attribute__((aligned(16))) unsigned char lds_raw[];
    LAS unsigned char* lds = (LAS unsigned char*)lds_raw;
    volatile LAS unsigned* MISC = (volatile LAS unsigned*)(lds + MISC_OFF);
    const int tid = threadIdx.x, lane = tid & 63, wave = __builtin_amdgcn_readfirstlane(tid >> 6);
    const int G = gridDim.x; const int bx = blockIdx.x;
    const int vcu = (G % 8 == 0) ? (bx % 8) * (G / 8) + bx / 8 : bx;
    unsigned char* ws = args.ws;
    const float* x = args.in[0];
    float* out = args.out;
    bf16_t* Win_t = (bf16_t*)(ws + WS_WIN); bf16_t* Wuq_t = (bf16_t*)(ws + WS_WUQ); bf16_t* Wukv_t = (bf16_t*)(ws + WS_WUKV); bf16_t* Wo_t = (bf16_t*)(ws + WS_WO);
    bf16_t* Wout_t = (bf16_t*)(ws + WS_WOUT); bf16_t* Wf1_t = (bf16_t*)(ws + WS_WF1); bf16_t* Wf2_t = (bf16_t*)(ws + WS_WF2);
    float* CSA = (float*)(ws + WS_CSA); float* CSB = (float*)(ws + WS_CSB); float* SSQ = (float*)(ws + WS_SSQ);
    bf16_t* XN = (bf16_t*)(ws + WS_XN); bf16_t* MKV = XN; bf16_t* HN = (bf16_t*)(ws + WS_HN);
    bf16_t* QKVA = (bf16_t*)(ws + WS_QKVA); bf16_t* QC = (bf16_t*)(ws + WS_QC); bf16_t* KVC = (bf16_t*)(ws + WS_KVC); bf16_t* KPE = (bf16_t*)(ws + WS_KPE);
    bf16_t* MQ = (bf16_t*)(ws + WS_MQ); bf16_t* MIX = (bf16_t*)(ws + WS_MIX); bf16_t* U = (bf16_t*)(ws + WS_U); bf16_t* HID = (bf16_t*)(ws + WS_HID);
    float* MIXF = (float*)(ws + WS_F32); float* FFO = (float*)(ws + WS_FFO);
    bf16_t* GATES = (bf16_t*)out;

    for (int u = tid; u < (LDS_BYTES - LDSCTL_OFF) / 4; u += NWAVES * 64) ((LAS unsigned*)(lds + LDSCTL_OFF))[u] = 0u;
    __syncthreads();
    XcdBarrier bar; bar.bar = (unsigned*)(ws + WS_CTL) + CW_BAR; bar.x = 0; bar.st = nullptr;
    if (N_LAUNCHES == 1) bar = xcd_barrier_post((unsigned*)(ws + WS_CTL) + CW_BAR, MISC + 8);
    const int lo = args.ph_lo, hi_ph = args.ph_hi;
#ifndef PH_MASK
#define PH_MASK 0x3ff
#endif
#ifndef REP_DIL
#define REP_DIL 1
#endif
#ifndef REP_MLA
#define REP_MLA 1
#endif
#ifndef REP_P0
#define REP_P0 1
#endif
#ifndef REP_P1
#define REP_P1 1
#endif
#define IN(k) (((PH_MASK >> (k)) & 1) && lo <= (k) && (k) < hi_ph)
#define SEAM(k) do { if (IN(k) && IN((k) + 1)) xcd_barrier(bar); } while (0)
    const int gw = vcu * NWAVES + wave, NGW = G * NWAVES;

    if (IN(0)) {
        LAS float* scr = (LAS float*)(lds + RING_OFF + wave * 16384);
        constexpr int I_IN = (1024 / 64) * (IN_TOTAL / 32), I_UQ = (512 / 64) * (768 / 32), I_UKV = (256 / 64) * (1024 / 32), I_OA = (256 / 64) * (1024 / 32), I_OB = (512 / 64) * (1024 / 32),
                      I_OUT = (1024 / 64) * (1024 / 32), I_F1 = (1024 / 64) * (4096 / 32), I_F2 = (4096 / 64) * (1024 / 32);
        constexpr int NITEMS = I_IN + I_UQ + I_UKV + I_OA + I_OB + I_OUT + I_F1 + I_F2;
        for (int it = gw; it < NITEMS; it += NGW) {
            int r = it;
            if (r < I_IN) { const int nblk = IN_TOTAL / 32, kb = r / nblk, nb = r % nblk, n0 = 32 * nb;
                int dshift = 0; if (n0 >= 3072 && n0 < 3104) dshift = 5120 - 3072; else if (n0 >= 3104) dshift = -32;
                transpose_item(args.in[2], IN_TOTAL, Win_t, 1024, 0, n0 + dshift, nullptr, scr, 64 * kb, n0, lane); continue; } r -= I_IN;
            if (r < I_UQ) { const int nblk = 768 / 32; transpose_item(args.in[5], 768, Wuq_t, 512, 0, 32 * (r % nblk), args.in[4], scr, 64 * (r / nblk), 32 * (r % nblk), lane); continue; } r -= I_UQ;
            if (r < I_UKV) { const int nblk = 1024 / 32; transpose_item(args.in[7], 1024, Wukv_t, 256, 0, 32 * (r % nblk), args.in[6], scr, 64 * (r / nblk), 32 * (r % nblk), lane); continue; } r -= I_UKV;
            if (r < I_OA) { const int nblk = 1024 / 32; transpose_item(args.in[8], 1024, Wo_t, 768, 0, 32 * (r % nblk), nullptr, scr, 64 * (r / nblk), 32 * (r % nblk), lane); continue; } r -= I_OA;
            if (r < I_OB) { const int nblk = 1024 / 32; transpose_item(args.in[9], 1024, Wo_t, 768, 256, 32 * (r % nblk), nullptr, scr, 64 * (r / nblk), 32 * (r % nblk), lane); continue; } r -= I_OB;
            if (r < I_OUT) { const int nblk = 1024 / 32; transpose_item(args.in[10], 1024, Wout_t, 1024, 0, 32 * (r % nblk), nullptr, scr, 64 * (r / nblk), 32 * (r % nblk), lane); continue; } r -= I_OUT;
            if (r < I_F1) { const int nblk = 4096 / 32; transpose_item(args.in[13], 4096, Wf1_t, 1024, 0, 32 * (r % nblk), nullptr, scr, 64 * (r / nblk), 32 * (r % nblk), lane); continue; } r -= I_F1;
            { const int nblk = 1024 / 32; transpose_item(args.in[14], 1024, Wf2_t, 4096, 0, 32 * (r % nblk), nullptr, scr, 64 * (r / nblk), 32 * (r % nblk), lane); }
        }
        for (int i = gw * 64 + lane; i < (NPROJ - IN_TOTAL) * 1024 / 8; i += NGW * 64) ((u32x4*)(Win_t + (size_t)IN_TOTAL * 1024))[i] = (u32x4){0u, 0u, 0u, 0u};
        for (int i = gw * 64 + lane; i < SEQ * 24; i += NGW * 64) {
            const int pos = i / 24, j = i % 24; const float inv = (j < 8) ? args.invA[j] : args.invB[j - 8];
            const float ang = (float)pos * inv; double rev = (double)ang * 0.15915494309189535; rev -= __builtin_floor(rev); const float fr = (float)rev;
            const float c = __builtin_amdgcn_cosf(fr), s = __builtin_amdgcn_sinf(fr);
            if (j < 8) { CSA[pos * 16 + j] = c; CSA[pos * 16 + 8 + j] = s; } else { CSB[pos * 32 + (j - 8)] = c; CSB[pos * 32 + 16 + (j - 8)] = s; }
        }
        const float* gpre = args.in[1];
        for (int m = gw; m < M; m += NGW) {
            const f32x4* xr = (const f32x4*)(x + (size_t)m * DM) + lane; f32x4 v[4]; float s = 0.f;
#pragma unroll
            for (int j = 0; j < 4; ++j) { v[j] = xr[64 * j]; s += (v[j].x * v[j].x + v[j].y * v[j].y) + (v[j].z * v[j].z + v[j].w * v[j].w); }
            const float rstd = __builtin_amdgcn_rsqf(wave_sum(s) * (1.f / DM) + EPS);
            unsigned long long* o8 = (unsigned long long*)(XN + (size_t)m * DM) + lane;
#pragma unroll
            for (int j = 0; j < 4; ++j) { const f32x4 gg = ((const f32x4*)gpre)[lane + 64 * j];
                o8[64 * j] = (unsigned long long)pk2(v[j].x * rstd * gg.x, v[j].y * rstd * gg.y) | ((unsigned long long)pk2(v[j].z * rstd * gg.z, v[j].w * rstd * gg.w) << 32); }
        }
    }
    SEAM(0);
    if (IN(1)) {
        pg8::Gemm g{XN, Win_t, 1024, 1024, 1024}; pg8::StaticOrder S; S.init(M, NPROJ, G, bx);
        pg8::Epi<0> E; E.a = pg8::EpiArgs{QKVA, QC, KVC, GATES, KPE, nullptr, SSQ, args.in[3], CSA, CSB, nullptr};
        pg8::gemm_phase(lds + RING_OFF, g, S, E);
    }
    SEAM(1);
    if (IN(2)) {
        { pg8::Gemm g{QC, Wuq_t, LD_QC, 512, 512}; pg8::StaticOrder S; S.init(M, 768, G, bx);
          pg8::Epi<1> E; E.a = pg8::EpiArgs{MQ, nullptr, nullptr, nullptr, nullptr, nullptr, SSQ, nullptr, CSA, CSB, nullptr};
          pg8::gemm_phase(lds + RING_OFF, g, S, E); }
        { pg8::Gemm g{KVC, Wukv_t, LD_KVC, 256, 256}; pg8::StaticOrder S; S.init(M, 1024, G, bx);
          pg8::Epi<2> E; E.a = pg8::EpiArgs{MKV, nullptr, nullptr, nullptr, nullptr, nullptr, SSQ, nullptr, CSA, CSB, nullptr};
          pg8::gemm_phase(lds + RING_OFF, g, S, E); }
    }
    SEAM(2);
    if (IN(3)) {
        for (int rep = 0; rep < REP_DIL; ++rep) {
            for (int task = gw; task < 2048; task += NGW) {
                const int cu = task >> 3, w = task & 7;
                att::dil_task(cu >> 7, (cu >> 1) & 3, (cu >> 3) & 15, ((cu & 1) << 3) | w, QKVA, MIX, lds + RING_OFF + wave * 4096);
            }
        }
        asm volatile("s_waitcnt vmcnt(0) lgkmcnt(0)" ::: "memory");
        __syncthreads();
        for (int rep = 0; rep < REP_MLA; ++rep) for (int uix = vcu; uix < 512; uix += G) {
            att::mla_unit((uix >> 5) >> 3, (uix >> 5) & 7, uix & 31, MQ, MKV, KPE, MIX, lds + RING_OFF);
        }
    }
    SEAM(3);
    if (IN(4)) {
        { pg8::Gemm g{MIX, Wo_t, LD_MIX, 768, 256}; pg8::StaticOrder S; S.init(M, 1024, G, bx);
          pg8::Epi<3> E; E.a = pg8::EpiArgs{U, nullptr, nullptr, nullptr, nullptr, nullptr, nullptr, nullptr, nullptr, nullptr, GATES};
          pg8::gemm_phase(lds + RING_OFF, g, S, E); }
        asm volatile("s_waitcnt vmcnt(0)" ::: "memory"); __syncthreads();
        { pg8::Gemm g{MIX + 256, Wo_t + 256, LD_MIX, 768, 512}; pg8::StaticOrder S; S.init(M, 1024, G, bx);
          pg8::Epi<4> E; E.a = pg8::EpiArgs{U, nullptr, nullptr, nullptr, nullptr, nullptr, nullptr, nullptr, nullptr, nullptr, GATES};
          pg8::gemm_phase(lds + RING_OFF, g, S, E); }
    }
    SEAM(4);
    if (IN(5)) {
        pg8::Gemm g{U, Wout_t, 1024, 1024, 1024}; pg8::StaticOrder S; S.init(M, 1024, G, bx);
        pg8::Epi<5> E; E.a = pg8::EpiArgs{nullptr, nullptr, nullptr, nullptr, nullptr, MIXF, SSQ, nullptr, nullptr, nullptr, nullptr};
        pg8::gemm_phase(lds + RING_OFF, g, S, E);
    }
    SEAM(5);
    if (IN(6)) {
        const float* gpost = args.in[11]; const float* gmlp = args.in[12];
        for (int m = gw; m < M; m += NGW) {
            float ss = 0.f; { const f32x4* sp = (const f32x4*)(SSQ + (size_t)m * 16);
#pragma unroll
                for (int j = 0; j < 4; ++j) { const f32x4 t = sp[j]; ss += (t.x + t.y) + (t.z + t.w); } }
            const float r1 = __builtin_amdgcn_rsqf(ss * (1.f / DM) + EPS);
            const f32x4* xr = (const f32x4*)(x + (size_t)m * DM) + lane; const f32x4* mr = (const f32x4*)(MIXF + (size_t)m * DM) + lane; f32x4* hr = (f32x4*)(out + (size_t)m * DM) + lane;
            f32x4 hv[4]; float s = 0.f;
#pragma unroll
            for (int j = 0; j < 4; ++j) { const f32x4 gg = ((const f32x4*)gpost)[lane + 64 * j]; hv[j] = xr[64 * j] + mr[64 * j] * r1 * gg; hr[64 * j] = hv[j]; s += (hv[j].x * hv[j].x + hv[j].y * hv[j].y) + (hv[j].z * hv[j].z + hv[j].w * hv[j].w); }
            const float r2 = __builtin_amdgcn_rsqf(wave_sum(s) * (1.f / DM) + EPS);
            unsigned long long* o8 = (unsigned long long*)(HN + (size_t)m * DM) + lane;
#pragma unroll
            for (int j = 0; j < 4; ++j) { const f32x4 gg = ((const f32x4*)gmlp)[lane + 64 * j];
                o8[64 * j] = (unsigned long long)pk2(hv[j].x * r2 * gg.x, hv[j].y * r2 * gg.y) | ((unsigned long long)pk2(hv[j].z * r2 * gg.z, hv[j].w * r2 * gg.w) << 32); }
        }
    }
    SEAM(6);
    if (IN(7)) {
        pg8::Gemm g{HN, Wf1_t, 1024, 1024, 1024}; pg8::StaticOrder S; S.init(M, FF, G, bx);
        pg8::Epi<6> E; E.a = pg8::EpiArgs{HID, nullptr, nullptr, nullptr, nullptr, nullptr, nullptr, nullptr, nullptr, nullptr, nullptr};
        pg8::gemm_phase(lds + RING_OFF, g, S, E);
    }
    SEAM(7);
    if (IN(8)) {
        pg8::Gemm g{HID, Wf2_t, FF, FF, FF}; pg8::StaticOrder S; S.init(M, 1024, G, bx);
        pg8::Epi<5> E; E.a = pg8::EpiArgs{nullptr, nullptr, nullptr, nullptr, nullptr, FFO, SSQ, nullptr, nullptr, nullptr, nullptr};
        pg8::gemm_phase(lds + RING_OFF, g, S, E);
    }
    SEAM(8);
    if (IN(9)) {
        const float* gp = args.in[15];
        for (int m = gw; m < M; m += NGW) {
            float ss = 0.f; { const f32x4* sp = (const f32x4*)(SSQ + (size_t)m * 16);
#pragma unroll
                for (int j = 0; j < 4; ++j) { const f32x4 t = sp[j]; ss += (t.x + t.y) + (t.z + t.w); } }
            const float r1 = __builtin_amdgcn_rsqf(ss * (1.f / DM) + EPS);
            const f32x4* fr = (const f32x4*)(FFO + (size_t)m * DM) + lane; f32x4* hr = (f32x4*)(out + (size_t)m * DM) + lane;
#pragma unroll
            for (int j = 0; j < 4; ++j) { const f32x4 gg = ((const f32x4*)gp)[lane + 64 * j]; hr[64 * j] = hr[64 * j] + fr[64 * j] * r1 * gg; }
        }
    }
#undef IN
#undef SEAM
}

extern "C" void kernel_launch(void* const* d_in, const int* in_sizes, int n_in, void* d_out, int out_size, void* d_ws, size_t ws_size, hipStream_t stream) {
    static int grid = 0;
    if (grid == 0) {
        if (n_in != 16 || in_sizes[0] != M * DM || out_size != M * DM || ws_size < 256 * MiB) { fprintf(stderr, "kernel_launch: unexpected shapes (n_in %d, ws %zu)\n", n_in, ws_size); grid = -1; return; }
        int dev = 0, cus = 0, per_cu = 0;
        if (hipGetDevice(&dev) != hipSuccess || hipDeviceGetAttribute(&cus, hipDeviceAttributeMultiprocessorCount, dev) != hipSuccess) { grid = -1; return; }
        if (hipFuncSetAttribute((const void*)mega_fwd, hipFuncAttributeMaxDynamicSharedMemorySize, LDS_BYTES) != hipSuccess) { fprintf(stderr, "kernel_launch: hipFuncSetAttribute failed\n"); grid = -1; return; }
        if (hipOccupancyMaxActiveBlocksPerMultiprocessor(&per_cu, (const void*)mega_fwd, NWAVES * 64, LDS_BYTES) != hipSuccess || per_cu < 1) fprintf(stderr, "kernel_launch: occupancy query says %d\n", per_cu);
        (void)hipGetLastError();
        grid = cus;
    }
    if (grid < 0) return;
    (void)hipMemsetAsync((char*)d_ws + WS_CTL, 0, CTL_ZERO_BYTES, stream);
    Args a{};
    for (int i = 0; i < 16; ++i) a.in[i] = (const float*)d_in[i];
    a.out = (float*)d_out; a.ws = (unsigned char*)d_ws;
    for (int i = 0; i < 8; ++i) a.invA[i] = powf(500000.0f, -((float)i * 2.0f / 16.0f));
    for (int i = 0; i < 16; ++i) a.invB[i] = powf(10000.0f, -((float)i * 2.0f / 32.0f));
    if (N_LAUNCHES == 1) { a.ph_lo = 0; a.ph_hi = N_PHASES; hipLaunchKernelGGL(mega_fwd, dim3(grid), dim3(NWAVES * 64), LDS_BYTES, stream, a); }
    else for (int p = 0; p < N_PHASES; ++p) { a.ph_lo = p; a.ph_hi = p + 1; hipLaunchKernelGGL(mega_fwd, dim3(grid), dim3(NWAVES * 64), LDS_BYTES, stream, a); }
}
```
